# Optimizing an MI355X kernel written in HIP

```python
import math
import jax, jax.numpy as jnp
from jax import lax
import numpy as np


D_MODEL = 1024
BATCH = 4
SEQ = 8192
DEPTH = 2

CHUNK = 64
N_MIXERS = 2
N_S5_LAYERS = (DEPTH + 1) // 2
N_RET_LAYERS = DEPTH // 2

S5_GROUP = 16
S5_GROUPS = D_MODEL // S5_GROUP
S5_STATE = 64
S5_DT_MIN = 1e-3
S5_DT_MAX = 1e-1

RET_QK_DIM = 256
RET_HEADS = D_MODEL // RET_QK_DIM
RET_V_DIM = 2 * RET_QK_DIM
RET_QK_WIDTH = RET_HEADS * RET_QK_DIM
RET_V_WIDTH = RET_HEADS * RET_V_DIM
RET_PROJ_WIDTH = 2 * RET_QK_WIDTH + 2 * RET_V_WIDTH
ROPE_BASE = 10000.0

FFN_HIDDEN = -(-8 * D_MODEL // (3 * 256)) * 256
NORM_EPS = 1e-6

kernel_name = 'chunk_causal_s5_retention_hybrid'


def rmsnorm(x, g):
    xf = x.astype(jnp.float32)
    y = xf * lax.rsqrt(jnp.mean(jnp.square(xf), axis=-1, keepdims=True) + NORM_EPS)
    return (y * g.astype(jnp.float32)).astype(x.dtype)


def swiglu(u, w_gate, w_up, w_down):
    h = jax.nn.silu(u @ w_gate.astype(u.dtype)) * (u @ w_up.astype(u.dtype))
    return h @ w_down.astype(u.dtype)


def _linear_recurrence_combine(e1, e2):
    a1, b1 = e1
    a2, b2 = e2
    return a1 * a2, a2 * b1 + b2


def s5_mixer(u, lam_re, lam_im, log_step, b_re, b_im, c_re, c_im, d, glu_w, glu_b):
    f32 = jnp.float32
    bsz, seq, _ = u.shape
    uf = u.astype(f32).reshape(bsz, seq, S5_GROUPS, S5_GROUP)
    lam = lax.complex(lam_re.astype(f32), lam_im.astype(f32))
    step = jnp.exp(log_step.astype(f32))[:, None]
    lam_bar = jnp.exp(lam * step)
    b = lax.complex(b_re.astype(f32), b_im.astype(f32))
    b_bar = ((lam_bar - 1.0) / lam)[..., None] * b
    bu = jnp.einsum('blgn,gpn->blgp', uf.astype(jnp.complex64), b_bar)
    a = jnp.broadcast_to(lam_bar, (1, seq, S5_GROUPS, S5_STATE))
    _, states = lax.associative_scan(_linear_recurrence_combine, (a, bu), axis=1)
    c = lax.complex(c_re.astype(f32), c_im.astype(f32))
    y = jnp.einsum('gnp,blgp->blgn', c, states).real + d.astype(f32) * uf
    y = jax.nn.gelu(y.reshape(bsz, seq, D_MODEL))
    y = y * jax.nn.sigmoid(y @ glu_w.astype(f32) + glu_b.astype(f32))
    return y.astype(u.dtype)


def _rotary_tables(seq):
    inv_freq = 1.0 / (ROPE_BASE ** jnp.linspace(0.0, 1.0, RET_QK_DIM // 2, dtype=jnp.float32))
    ang = jnp.arange(seq, dtype=jnp.float32)[:, None] * inv_freq[None, :]
    return jnp.cos(ang)[None, :, None, :], jnp.sin(ang)[None, :, None, :]


def _apply_rotary(t, cos, sin):
    t1, t2 = jnp.split(t, 2, axis=-1)
    return jnp.concatenate([t1 * cos - t2 * sin, t1 * sin + t2 * cos], axis=-1)


def retention_mixer(u, w_qkvg, gn_w, w_o):
    f32 = jnp.float32
    bsz, seq, _ = u.shape
    n_chunks = seq // CHUNK
    proj = jnp.matmul(u, w_qkvg.astype(u.dtype)).astype(f32)
    q, k, v, g = jnp.split(proj, [RET_QK_WIDTH, 2 * RET_QK_WIDTH, 2 * RET_QK_WIDTH + RET_V_WIDTH], axis=-1)
    q = q.reshape(bsz, seq, RET_HEADS, RET_QK_DIM)
    k = k.reshape(bsz, seq, RET_HEADS, RET_QK_DIM) * (RET_QK_DIM ** -0.5)
    v = v.reshape(bsz, seq, RET_HEADS, RET_V_DIM)
    cos, sin = _rotary_tables(seq)
    q = _apply_rotary(q, cos, sin)
    k = _apply_rotary(k, cos, sin)

    log_gamma = jnp.log1p(-jnp.exp2(-5.0 - jnp.arange(RET_HEADS, dtype=f32)))
    pos = jnp.arange(CHUNK, dtype=f32)
    intra_decay = jnp.exp(log_gamma[:, None, None] * jnp.abs(pos[:, None] - pos[None, :]))
    q_decay = jnp.exp((pos[:, None] + 1.0) * log_gamma[None, :])
    k_decay = jnp.exp((CHUNK - 1.0 - pos)[:, None] * log_gamma[None, :])
    chunk_decay = jnp.exp(CHUNK * log_gamma)

    def to_chunks(t):
        return t.reshape(bsz, n_chunks, CHUNK, RET_HEADS, t.shape[-1]).swapaxes(0, 1)

    def step(state, qkv):
        qc, kc, vc = qkv
        scores = jnp.einsum('bihd,bjhd->bhij', qc, kc) * intra_decay
        o_intra = jnp.einsum('bhij,bjhe->bihe', scores, vc)
        o_cross = jnp.einsum('bihd,bhde->bihe', qc * q_decay[None, :, :, None], state)
        new_state = state * chunk_decay[None, :, None, None] + jnp.einsum(
            'bjhd,bjhe->bhde', kc * k_decay[None, :, :, None], vc)
        return new_state, o_intra + o_cross

    state0 = jnp.zeros((bsz, RET_HEADS, RET_QK_DIM, RET_V_DIM), f32)
    _, o = lax.scan(step, state0, (to_chunks(q), to_chunks(k), to_chunks(v)))
    o = o.swapaxes(0, 1).reshape(bsz, seq, RET_HEADS, RET_V_DIM)
    mean = jnp.mean(o, axis=-1, keepdims=True)
    var = jnp.mean(jnp.square(o - mean), axis=-1, keepdims=True)
    o = ((o - mean) * lax.rsqrt(var + NORM_EPS)).reshape(bsz, seq, RET_V_WIDTH) * gn_w.astype(f32)
    y = jax.nn.silu(g) * o
    return jnp.matmul(y.astype(u.dtype), w_o.astype(u.dtype))


def setup_inputs(seed: int = 0) -> dict:
    key = jax.random.key(seed)
    ks = jax.random.split(key, 24)
    f32 = jnp.float32
    nrm = lambda k, s, sc: jax.random.normal(k, s, f32) * sc
    x = jax.random.normal(ks[0], (BATCH, SEQ, D_MODEL), f32)

    s5_norm = 1.0 + nrm(ks[1], (N_S5_LAYERS, D_MODEL), 0.02)
    s5_lambda_re = -0.5 + nrm(ks[2], (N_S5_LAYERS, S5_GROUPS, S5_STATE), 0.01)
    s5_lambda_im = (math.pi * jnp.arange(S5_STATE, dtype=f32))[None, None, :] + nrm(
        ks[3], (N_S5_LAYERS, S5_GROUPS, S5_STATE), 0.01)
    s5_log_step = jax.random.uniform(ks[4], (N_S5_LAYERS, S5_GROUPS), f32,
                                     math.log(S5_DT_MIN), math.log(S5_DT_MAX))
    b_scale = (2.0 * S5_GROUP) ** -0.5
    s5_b_re = nrm(ks[5], (N_S5_LAYERS, S5_GROUPS, S5_STATE, S5_GROUP), b_scale)
    s5_b_im = nrm(ks[6], (N_S5_LAYERS, S5_GROUPS, S5_STATE, S5_GROUP), b_scale)
    c_scale = S5_STATE ** -0.5
    s5_c_re = nrm(ks[7], (N_S5_LAYERS, S5_GROUPS, S5_GROUP, S5_STATE), c_scale)
    s5_c_im = nrm(ks[8], (N_S5_LAYERS, S5_GROUPS, S5_GROUP, S5_STATE), c_scale)
    s5_d = nrm(ks[9], (N_S5_LAYERS, S5_GROUPS, S5_GROUP), 1.0)
    s5_glu_w = nrm(ks[10], (N_S5_LAYERS, D_MODEL, D_MODEL), D_MODEL ** -0.5)
    s5_glu_b = nrm(ks[11], (N_S5_LAYERS, D_MODEL), 0.01)

    ret_norm = 1.0 + nrm(ks[12], (N_RET_LAYERS, D_MODEL), 0.02)
    ret_w_qkvg = nrm(ks[13], (N_RET_LAYERS, D_MODEL, RET_PROJ_WIDTH), D_MODEL ** -0.5)
    ret_gn_w = 1.0 + nrm(ks[14], (N_RET_LAYERS, RET_V_WIDTH), 0.02)
    ret_w_o = nrm(ks[15], (N_RET_LAYERS, RET_V_WIDTH, D_MODEL), RET_V_WIDTH ** -0.5)

    ffn_norm = 1.0 + nrm(ks[16], (DEPTH, D_MODEL), 0.02)
    ffn_w_gate = nrm(ks[17], (DEPTH, D_MODEL, FFN_HIDDEN), D_MODEL ** -0.5)
    ffn_w_up = nrm(ks[18], (DEPTH, D_MODEL, FFN_HIDDEN), D_MODEL ** -0.5)
    ffn_w_down = nrm(ks[19], (DEPTH, FFN_HIDDEN, D_MODEL), FFN_HIDDEN ** -0.5)
    final_norm = 1.0 + nrm(ks[20], (D_MODEL,), 0.02)
    return {'x': x, 's5_norm': s5_norm, 's5_lambda_re': s5_lambda_re, 's5_lambda_im': s5_lambda_im,
            's5_log_step': s5_log_step, 's5_b_re': s5_b_re, 's5_b_im': s5_b_im,
            's5_c_re': s5_c_re, 's5_c_im': s5_c_im, 's5_d': s5_d,
            's5_glu_w': s5_glu_w, 's5_glu_b': s5_glu_b,
            'ret_norm': ret_norm, 'ret_w_qkvg': ret_w_qkvg, 'ret_gn_w': ret_gn_w, 'ret_w_o': ret_w_o,
            'ffn_norm': ffn_norm, 'ffn_w_gate': ffn_w_gate, 'ffn_w_up': ffn_w_up,
            'ffn_w_down': ffn_w_down, 'final_norm': final_norm}


def reference(x, s5_norm, s5_lambda_re, s5_lambda_im, s5_log_step, s5_b_re, s5_b_im,
              s5_c_re, s5_c_im, s5_d, s5_glu_w, s5_glu_b,
              ret_norm, ret_w_qkvg, ret_gn_w, ret_w_o,
              ffn_norm, ffn_w_gate, ffn_w_up, ffn_w_down, final_norm):
    for i in range(DEPTH):
        j = i // N_MIXERS
        if i % N_MIXERS == 0:
            x = x + s5_mixer(rmsnorm(x, s5_norm[j]), s5_lambda_re[j], s5_lambda_im[j],
                             s5_log_step[j], s5_b_re[j], s5_b_im[j], s5_c_re[j], s5_c_im[j],
                             s5_d[j], s5_glu_w[j], s5_glu_b[j])
        else:
            x = x + retention_mixer(rmsnorm(x, ret_norm[j]), ret_w_qkvg[j], ret_gn_w[j], ret_w_o[j])
        x = x + swiglu(rmsnorm(x, ffn_norm[i]), ffn_w_gate[i], ffn_w_up[i], ffn_w_down[i])
    return rmsnorm(x, final_norm)
```

```cpp
#include <hip/hip_runtime.h>
#include <hip/hip_cooperative_groups.h>
#include <cstdio>
#include <cstdint>
#define MK_MODE 3
#define LAS __attribute__((address_space(3)))
#define GAS __attribute__((address_space(1)))
namespace mk {
typedef unsigned short bf16;
typedef short bf16x8 __attribute__((ext_vector_type(8)));
typedef short s16x4 __attribute__((ext_vector_type(4)));
typedef float f32x4 __attribute__((ext_vector_type(4)));
typedef unsigned u32x4 __attribute__((ext_vector_type(4)));
typedef unsigned u32x2 __attribute__((ext_vector_type(2)));
typedef __bf16 bf2_t __attribute__((ext_vector_type(2)));
typedef float f2_t __attribute__((ext_vector_type(2)));

constexpr int T = 32768, D = 1024, L = 8192, FF = 2816, PW = 6144, NWAVES = 8, NTHREADS = 512;
constexpr float EPS = 1e-6f;
constexpr float LOG2_ROPE = 13.287712379549449f;

constexpr size_t MiB = (size_t)1 << 20;
constexpr size_t WS_CTL = 0;
constexpr size_t WS_SSQ = 1 * MiB;
constexpr size_t WS_WGLU = 8 * MiB;
constexpr size_t WS_WGU0 = 10 * MiB, WS_WGU1 = 21 * MiB;
constexpr size_t WS_WDN0 = 32 * MiB, WS_WDN1 = 38 * MiB;
constexpr size_t WS_WQKVG = 44 * MiB;
constexpr size_t WS_WO = 56 * MiB;
constexpr size_t WS_XB = 64 * MiB;
constexpr size_t WS_U = 128 * MiB, WS_YG = 192 * MiB, WS_S5C = 256 * MiB;
constexpr size_t WS_H = 128 * MiB;
constexpr size_t WS_Q = 128 * MiB, WS_K = 192 * MiB, WS_VD = 256 * MiB, WS_SG = 384 * MiB;
constexpr size_t WS_END = 512 * MiB;
constexpr int S5C_TILES = 0, S5C_WIN = 16384, S5C_WOUT = 16384 + 65536, S5C_A16 = 16384 + 2 * 65536, S5C_STRIDE = S5C_A16 + 512;

constexpr int LDS_BYTES = 148480;

__device__ __forceinline__ unsigned pk2(float lo, float hi) { f2_t v = {lo, hi}; return __builtin_bit_cast(unsigned, __builtin_convertvector(v, bf2_t)); }
__device__ __forceinline__ float bf_lo(unsigned u) { return __uint_as_float(u << 16); }
__device__ __forceinline__ float bf_hi(unsigned u) { return __uint_as_float(u & 0xffff0000u); }
__device__ __forceinline__ float fast_sigmoid(float z) { return __builtin_amdgcn_rcpf(1.0f + __expf(-z)); }
__device__ __forceinline__ float fast_silu(float z) { return z * fast_sigmoid(z); }
__device__ __forceinline__ float log2_gamma(int h) { return log1pf(-exp2f(-5.0f - (float)h)) * 1.4426950408889634f; }
__device__ __forceinline__ void sincos_rev(float x, float& s, float& c) {
    const float hi = x * 0.15915494309189535f;
    const float lo = fmaf(x, 0.15915494309189535f, -hi) + x * 6.4206383e-9f;
    const float fr = (hi - rintf(hi)) + lo;
    s = __builtin_amdgcn_sinf(fr); c = __builtin_amdgcn_cosf(fr);
}
__device__ __forceinline__ float gelu_tanh(float y) {
    const float z = 0.7978845608028654f * (y + 0.044715f * y * y * y);
    const float e = __expf(2.0f * z);
    return 0.5f * y * (2.0f - 2.0f * __builtin_amdgcn_rcpf(e + 1.0f));
}
__device__ __forceinline__ float wave_sum(float v) {
#pragma unroll
    for (int o = 1; o < 64; o <<= 1) v += __shfl_xor(v, o);
    return v;
}
#ifdef MK_TIMING
#define TS_BASE(ldsp) ((volatile LAS unsigned long long*)((ldsp) + mk::LDS_BYTES - 256 + 64))
#define TS_STAMP(ldsp, wv, k) do { if (blockIdx.x == 0 && (wv) == TWAVE && (threadIdx.x & 63) == 0) { volatile LAS unsigned long long* t_ = TS_BASE(ldsp); const unsigned long long n_ = __builtin_amdgcn_s_memtime(); \
        if ((k) >= 0) t_[1 + ((k) < 0 ? 0 : (k))] += n_ - t_[0]; t_[0] = n_; } } while (0)
#define TS_START(F) TS_STAMP(F.lds, F.wave, -1)
#define TS(F, k) TS_STAMP(F.lds, F.wave, k)
#define TSG(k) TS_STAMP(lds, wid, k)
#define TS_SPIN(F) do { __syncthreads(); if (blockIdx.x == 0 && F.wave == TWAVE && F.lane == 0) { const unsigned long long d_ = TS_BASE(F.lds)[1 + TSEL] * (unsigned long long)(TAMP); \
        const unsigned long long t0_ = __builtin_amdgcn_s_memtime(); while (__builtin_amdgcn_s_memtime() - t0_ < d_) __builtin_amdgcn_s_sleep(8); } } while (0)
#else
#define TS_START(F) do {} while (0)
#define TS(F, k) do {} while (0)
#define TSG(k) do {} while (0)
#define TS_SPIN(F) do {} while (0)
#endif
#ifndef TGRP
#define TGRP 0
#endif
#define TS_MEMBERS
#define TS_INIT(F) do {} while (0)
}
namespace mk {
typedef GAS unsigned gu32;
#define RLX_AGENT __ATOMIC_RELAXED, __HIP_MEMORY_SCOPE_AGENT
#define XB_TMO      128
#define XB_XCNT(j)  (256  + 64 * (j))
#define XB_XSUB(j)  (1280 + 64 * (j))
#define XB_XGEN(j)  (2304 + 64 * (j))
#define XB_TOP      3328
#define XB_TOPGEN   3392
#define XCD_BAR_WORDS 3456
#define XB_SPIN_CAP (1u << 18)

__device__ __forceinline__ unsigned xb_ld(unsigned* p)              { return __hip_atomic_load(p, __ATOMIC_RELAXED, __HIP_MEMORY_SCOPE_AGENT); }
__device__ __forceinline__ unsigned xb_add(unsigned* p, unsigned v) { return __hip_atomic_fetch_add(p, v, __ATOMIC_RELAXED, __HIP_MEMORY_SCOPE_AGENT); }
__device__ __forceinline__ unsigned xb_xcc_id() { return (unsigned)__builtin_amdgcn_s_getreg((3 << 11) | 20) & 0xFu; }
#define XB_SPIN(cond, bar) do { unsigned _sp = 0; while (cond) { __builtin_amdgcn_s_sleep(1); \
    if ((++_sp & 255u) == 0u) { if (xb_ld(&(bar)[XB_TMO])) break; if (_sp > XB_SPIN_CAP) { atomicAdd(&(bar)[XB_TMO], 1u); break; } } } } while (0)

struct XcdBarrier {
    unsigned* bar; unsigned x;
    volatile LAS unsigned* st;
};

__device__ __forceinline__ XcdBarrier xcd_barrier_post(unsigned* bar, volatile LAS unsigned* st) {
    XcdBarrier b; b.bar = bar; b.x = xb_xcc_id(); b.st = st;
    if (threadIdx.x == 0) (void)xb_add(&bar[XB_XCNT(b.x)], 1u);
    return b;
}
__device__ __forceinline__ void xcd_barrier_complete(unsigned* bar, unsigned x, unsigned& nloc, unsigned& nx) {
    const unsigned G = gridDim.x * gridDim.y * gridDim.z;
    unsigned sum, cnt, mine, sp = 0u;
    for (;;) {
        sum = 0u; cnt = 0u; mine = 0u;
#pragma unroll
        for (unsigned j = 0; j < 16; ++j) { const unsigned c = xb_ld(&bar[XB_XCNT(j)]); sum += c; cnt += (c > 0u) ? 1u : 0u; mine = (j == x) ? c : mine; }
        if (sum == G) break;
        __builtin_amdgcn_s_sleep(1);
        if ((++sp & 255u) == 0u) { if (xb_ld(&bar[XB_TMO])) break; if (sp > XB_SPIN_CAP) { atomicAdd(&bar[XB_TMO], 1u); break; } }
    }
    nloc = mine > 0u ? mine : 1u; nx = cnt > 0u ? cnt : 1u;
}

__device__ __forceinline__ void xcd_barrier(const XcdBarrier& b) {
    asm volatile("s_waitcnt vmcnt(0)" ::: "memory");
    __syncthreads();
    if (threadIdx.x == 0) {
        unsigned* bar = b.bar;
        __builtin_amdgcn_s_waitcnt(0);
        unsigned nloc = b.st[0], nx = b.st[1];
        if (nloc == 0u) { xcd_barrier_complete(bar, b.x, nloc, nx); b.st[0] = nloc; b.st[1] = nx; }
        const unsigned old = xb_add(&bar[XB_XSUB(b.x)], 1u);
        const unsigned gen = old / nloc;
        if (old + 1u == (gen + 1u) * nloc) {
            __builtin_amdgcn_fence(__ATOMIC_RELEASE, "agent");
            asm volatile("s_waitcnt vmcnt(0)" ::: "memory");
            const unsigned og = xb_add(&bar[XB_TOP], 1u);
            const unsigned tg = og / nx;
            if (og + 1u == (tg + 1u) * nx) xb_add(&bar[XB_TOPGEN], 1u);
            else XB_SPIN(xb_ld(&bar[XB_TOPGEN]) == tg, bar);
            __builtin_amdgcn_fence(__ATOMIC_ACQUIRE, "agent");
            xb_add(&bar[XB_XGEN(b.x)], 1u);
            asm volatile("s_waitcnt vmcnt(0)" ::: "memory");
        } else {
            XB_SPIN(xb_ld(&bar[XB_XGEN(b.x)]) == gen, bar);
            __builtin_amdgcn_fence(__ATOMIC_ACQUIRE, "agent");
            asm volatile("s_waitcnt vmcnt(0)" ::: "memory");
        }
    }
    __syncthreads();
}
}
namespace pg8 {
#define PG8_LAS __attribute__((address_space(3)))
typedef unsigned short bf16_t;
typedef short bf16x8 __attribute__((ext_vector_type(8)));
typedef float f32x4 __attribute__((ext_vector_type(4)));
typedef unsigned u32x4 __attribute__((ext_vector_type(4)));
constexpr int BM = 256, BK = 64, HALF = 128, HTB = HALF * BK * 2  , STAGE_BYTES = 8 * HTB, NXCD = 8, WGM = 8;

__host__ __device__ __forceinline__ int lds_byte(int r, int c) { const int st = (r >> 4) * 2 + (c >> 5), rr = r & 15, cc = c & 31, ob = rr * 64 + cc * 2; return st * 1024 + (ob ^ (((ob >> 9) & 1) << 5)); }
__host__ __device__ __forceinline__ void stage_rc(int b, int& R, int& C) { const int st = b / 1024, sb = b % 1024, swz = sb ^ (((sb >> 9) & 1) << 5); R = (st >> 1) * 16 + swz / 64; C = (st & 1) * 32 + (swz % 64) / 2; }
__host__ __device__ __forceinline__ int perm32(int rho) { const int n = rho >> 4, i = rho & 15; return 8 * (i >> 2) + 4 * n + (i & 3); }

struct Unit { int pm, pn; };
struct Gemm { const bf16_t* A; const bf16_t* Bt; int M, N, K; };

struct StaticOrder {
    int nM, nN, nwg, G, c;
    __host__ __device__ void init(int M, int N, int G_, int c_) { nM = M / BM; nN = N / BM; nwg = nM * nN; G = G_; c = c_; }
    __host__ __device__ bool next(int i, Unit& u) const {
        const long L = (long)i * G + c; if (L >= nwg) return false;
        int wgid = (int)L; { const int q = nwg / NXCD, r = nwg % NXCD, xcd = wgid % NXCD, off = wgid / NXCD; wgid = (xcd < r ? xcd * (q + 1) : r * (q + 1) + (xcd - r) * q) + off; }
        const int nig = WGM * nN, gid = wgid / nig, fm = gid * WGM, gsz = (nM - fm) < WGM ? (nM - fm) : WGM;
        u.pm = fm + ((wgid % nig) % gsz); u.pn = (wgid % nig) / gsz; return true;
    }
    __device__ __forceinline__ void a_ready(const Unit&) const {}
    __device__ __forceinline__ void done(const Unit&) const {}
};

__device__ __forceinline__ unsigned cvt_pk_bf16(float lo, float hi) { unsigned r; asm volatile("v_cvt_pk_bf16_f32 %0, %1, %2" : "=v"(r) : "v"(lo), "v"(hi)); return r; }
typedef float f32x2 __attribute__((ext_vector_type(2)));
template <class Epi, class Sched, bool ALIGN_EPI = false, bool SP2 = false, bool TIMED = false>
__device__ __forceinline__ void gemm_phase(PG8_LAS unsigned char* lds, const Gemm g, const Sched& S, const Epi& E) {
    const int tid = threadIdx.x, wid = __builtin_amdgcn_readfirstlane(tid >> 6), lane = tid & 63, wr = wid >> 2, wc = wid & 3, fr = lane & 15, fq = lane >> 4;
    const int K = g.K, nt = K / BK;
    unsigned voffA[2], voffB[2];
#pragma unroll
    for (int i = 0; i < 2; ++i) { int R, C; stage_rc(tid * 16 + i * 8192, R, C); const int Rb = Epi::PERM ? ((R & ~31) + perm32(R & 31)) : R;
        voffA[i] = (unsigned)(R * K + C) * 2u; voffB[i] = (unsigned)(Rb * K + C) * 2u; }
    const size_t kstep = (size_t)(BK * 2);
    const size_t hstep = (size_t)HALF * K * 2;
    const size_t tstep = 2 * hstep;
    const unsigned ldsw = (unsigned)wid * 1024u;
    const int aoff = lds_byte(wr * 64 + fr, fq * 8), boff = lds_byte(wc * 32 + fr, fq * 8);
#define PG8_SA(b, h) (((b) * 2 + (h)) * HTB)
#define PG8_SB(b, h) ((4 + (b) * 2 + (h)) * HTB)
#define PG8_STAGE(bufoff, gbase, voff) do { _Pragma("unroll") for (int _i = 0; _i < 2; ++_i) \
        __builtin_amdgcn_global_load_lds((const unsigned*)((const char*)(gbase) + (voff)[_i]), (PG8_LAS unsigned*)(lds + (bufoff) + ldsw + _i * 8192), 16, 0, 0); } while (0)
#define PG8_LDA(dst, b, h) do { _Pragma("unroll") for (int m = 0; m < 4; ++m) _Pragma("unroll") for (int k = 0; k < 2; ++k) dst[m][k] = *(const PG8_LAS bf16x8*)(lds + PG8_SA(b, h) + aoff + m * 2048 + k * 1024); } while (0)
#define PG8_LDB(dst, b, h) do { _Pragma("unroll") for (int n = 0; n < 2; ++n) _Pragma("unroll") for (int k = 0; k < 2; ++k) dst[n][k] = *(const PG8_LAS bf16x8*)(lds + PG8_SB(b, h) + boff + n * 2048 + k * 1024); } while (0)
#define PG8_MMA(ai, bj, At, Bt) do { __builtin_amdgcn_s_setprio(1); _Pragma("unroll") for (int m = 0; m < 4; ++m) _Pragma("unroll") for (int n = 0; n < 2; ++n) _Pragma("unroll") for (int k = 0; k < 2; ++k) \
        acc[ai][bj][m][n] = __builtin_amdgcn_mfma_f32_16x16x32_bf16(Bt[n][k], At[m][k], acc[ai][bj][m][n], 0, 0, 0); __builtin_amdgcn_s_setprio(0); } while (0)
#define PG8_WAIT_V(n) asm volatile("s_waitcnt vmcnt(" #n ")" ::: "memory")
#define PG8_WAIT_L(n) asm volatile("s_waitcnt lgkmcnt(" #n ")" ::: "memory")
#define PG8_BAR __builtin_amdgcn_s_barrier()
#define PG8_SCHED __builtin_amdgcn_sched_barrier(0)
    Unit cur, nxt; int ui = 0;
    if (!S.next(0, cur)) return;
    f32x4 acc[2][2][4][2];
#pragma unroll
    for (int a = 0; a < 2; ++a)
#pragma unroll
        for (int b = 0; b < 2; ++b)
#pragma unroll
            for (int m = 0; m < 4; ++m)
#pragma unroll
                for (int n = 0; n < 2; ++n) acc[a][b][m][n] = (f32x4){0.f, 0.f, 0.f, 0.f};
    bf16x8 At[4][2], B0[2][2], B1[2][2];
    const char* cA = (const char*)g.A + (size_t)cur.pm * tstep; const char* cB = (const char*)g.Bt + (size_t)cur.pn * tstep;
    S.a_ready(cur);
    if constexpr (SP2) {
        PG8_STAGE(PG8_SB(0, 0), cB, voffB); PG8_STAGE(PG8_SB(0, 1), cB + hstep, voffB); PG8_STAGE(PG8_SA(0, 0), cA, voffA); PG8_STAGE(PG8_SA(0, 1), cA + hstep, voffA);
        if (wr == 1) PG8_BAR;
        PG8_WAIT_V(2); PG8_BAR;
        PG8_STAGE(PG8_SB(1, 0), cB + kstep, voffB); PG8_STAGE(PG8_SA(1, 0), cA + kstep, voffA); PG8_STAGE(PG8_SB(1, 1), cB + hstep + kstep, voffB);
        PG8_WAIT_V(6); PG8_BAR;
    } else {
        PG8_STAGE(PG8_SB(0, 0), cB, voffB); PG8_STAGE(PG8_SA(0, 0), cA, voffA); PG8_STAGE(PG8_SB(0, 1), cB + hstep, voffB); PG8_STAGE(PG8_SA(0, 1), cA + hstep, voffA);
        if (wr == 1) PG8_BAR;
        PG8_WAIT_V(4); PG8_BAR;
        PG8_STAGE(PG8_SB(1, 0), cB + kstep, voffB); PG8_STAGE(PG8_SA(1, 0), cA + kstep, voffA); PG8_STAGE(PG8_SB(1, 1), cB + hstep + kstep, voffB);
        PG8_WAIT_V(6); PG8_BAR;
    }
    if (TIMED) TSG(3);
    for (;;) {
        const bool has_next = S.next(ui + 1, nxt);
        const char* nA = has_next ? (const char*)g.A + (size_t)nxt.pm * tstep : cA; const char* nB = has_next ? (const char*)g.Bt + (size_t)nxt.pn * tstep : cB;
        for (int t = 0; t < nt; t += 2) {
            const bool last = (t == nt - 2);
            const char* a1 = cA + (size_t)(t + 1) * kstep;
            const char* a2 = last ? nA : cA + (size_t)(t + 2) * kstep; const char* b2 = last ? nB : cB + (size_t)(t + 2) * kstep;
            const char* a3 = a2 + kstep; const char* b3 = b2 + kstep;
            if (last && has_next) S.a_ready(nxt);
            if (last) E.prefetch(cur, wid, lds + STAGE_BYTES);
            if constexpr (SP2) {
            PG8_LDB(B0, 0, 0); PG8_LDB(B1, 0, 1); PG8_SCHED; PG8_LDA(At, 0, 0); PG8_STAGE(PG8_SA(1, 1), a1 + hstep, voffA);
            PG8_WAIT_V(8); PG8_WAIT_L(0); PG8_BAR; PG8_MMA(0, 0, At, B0); PG8_MMA(0, 1, At, B1); PG8_BAR; PG8_SCHED;
            PG8_LDA(At, 0, 1); PG8_STAGE(PG8_SB(0, 0), b2, voffB); PG8_STAGE(PG8_SB(0, 1), b2 + hstep, voffB); PG8_STAGE(PG8_SA(0, 0), a2, voffA);
            PG8_WAIT_V(8); PG8_WAIT_L(0); PG8_BAR; PG8_MMA(1, 0, At, B0); PG8_MMA(1, 1, At, B1); PG8_BAR; PG8_SCHED;
            PG8_LDB(B0, 1, 0); PG8_LDB(B1, 1, 1); PG8_SCHED; PG8_LDA(At, 1, 0); PG8_STAGE(PG8_SA(0, 1), a2 + hstep, voffA);
            PG8_WAIT_V(8); PG8_WAIT_L(0); PG8_BAR; PG8_MMA(0, 0, At, B0); PG8_MMA(0, 1, At, B1); PG8_BAR; PG8_SCHED;
            PG8_LDA(At, 1, 1); PG8_STAGE(PG8_SB(1, 0), b3, voffB); PG8_STAGE(PG8_SB(1, 1), b3 + hstep, voffB); PG8_STAGE(PG8_SA(1, 0), a3, voffA);
            PG8_WAIT_V(8); PG8_WAIT_L(0); PG8_BAR; PG8_MMA(1, 0, At, B0); PG8_MMA(1, 1, At, B1); PG8_BAR; PG8_SCHED;
            } else {
            PG8_LDB(B0, 0, 0); PG8_SCHED; PG8_LDA(At, 0, 0); PG8_STAGE(PG8_SA(1, 1), a1 + hstep, voffA);
            PG8_WAIT_L(8); PG8_BAR; PG8_WAIT_L(0); PG8_MMA(0, 0, At, B0); PG8_BAR; PG8_SCHED;
            PG8_LDB(B1, 0, 1); PG8_STAGE(PG8_SB(0, 0), b2, voffB);
            PG8_BAR; PG8_WAIT_L(0); PG8_MMA(0, 1, At, B1); PG8_BAR;
            PG8_LDA(At, 0, 1); PG8_STAGE(PG8_SA(0, 0), a2, voffA);
            PG8_BAR; PG8_WAIT_L(0); PG8_MMA(1, 0, At, B0); PG8_BAR; PG8_SCHED;
            PG8_STAGE(PG8_SB(0, 1), b2 + hstep, voffB);
            PG8_WAIT_V(6); PG8_BAR; PG8_MMA(1, 1, At, B1); PG8_BAR;
            PG8_LDB(B0, 1, 0); PG8_SCHED; PG8_LDA(At, 1, 0); PG8_STAGE(PG8_SA(0, 1), a2 + hstep, voffA);
            PG8_WAIT_L(8); PG8_BAR; PG8_WAIT_L(0); PG8_MMA(0, 0, At, B0); PG8_BAR; PG8_SCHED;
            PG8_LDB(B1, 1, 1); PG8_STAGE(PG8_SB(1, 0), b3, voffB);
            PG8_BAR; PG8_WAIT_L(0); PG8_MMA(0, 1, At, B1); PG8_BAR;
            PG8_LDA(At, 1, 1); PG8_STAGE(PG8_SA(1, 0), a3, voffA);
            PG8_BAR; PG8_WAIT_L(0); PG8_MMA(1, 0, At, B0); PG8_BAR; PG8_SCHED;
            PG8_STAGE(PG8_SB(1, 1), b3 + hstep, voffB);
            PG8_WAIT_V(6); PG8_BAR; PG8_MMA(1, 1, At, B1); PG8_BAR;
            }
        }
        if (TIMED) TSG(0);
        if constexpr (ALIGN_EPI) { if (wr == 0) PG8_BAR; }
        if constexpr (!Epi::AFTER_DRAIN) { E(acc, cur, wr, wc, fr, fq); S.done(cur); }
        if (TIMED) TSG(1);
        if (!has_next) break;
#pragma unroll
        for (int a = 0; a < 2; ++a)
#pragma unroll
            for (int b = 0; b < 2; ++b)
#pragma unroll
                for (int m = 0; m < 4; ++m)
#pragma unroll
                    for (int n = 0; n < 2; ++n) acc[a][b][m][n] = (f32x4){0.f, 0.f, 0.f, 0.f};
        cur = nxt; cA = nA; cB = nB; ++ui;
        if constexpr (ALIGN_EPI) { if (wr == 1) PG8_BAR; }
    }
    PG8_WAIT_V(0);
    if constexpr (!ALIGN_EPI) { if (wr == 0) PG8_BAR; }
    PG8_BAR;
    if constexpr (Epi::AFTER_DRAIN) { E.fused(acc, cur, wr, wc, fr, fq, lds, wid, lane); S.done(cur); }
#undef PG8_SA
#undef PG8_SB
#undef PG8_STAGE
#undef PG8_LDA
#undef PG8_LDB
#undef PG8_MMA
#undef PG8_WAIT_V
#undef PG8_WAIT_L
#undef PG8_BAR
#undef PG8_SCHED
}
}
namespace pg8 {
using mk::pk2; using mk::bf_lo; using mk::bf_hi;
__device__ __forceinline__ float row_rstd(const float* part, int r, int fq) {
    const f32x4 v = *(const f32x4*)(part + (size_t)r * 16 + 4 * fq);
    float s = (v[0] + v[1]) + (v[2] + v[3]);
    s += __shfl_xor(s, 16); s += __shfl_xor(s, 32);
    return rsqrtf(s * (1.0f / 1024.0f) + mk::EPS);
}
template <bool GLU> struct EpiResid {
    static constexpr bool PERM = true, AFTER_DRAIN = false;
    __device__ __forceinline__ void prefetch(const Unit&, int, PG8_LAS unsigned char*) const {}
    const float* xin; bf16_t* xb; float* part; const bf16_t* Yg; const float* bias;
    __device__ __forceinline__ void operator()(const f32x4 (&acc)[2][2][4][2], const Unit& u, int wr, int wc, int fr, int fq) const {
        const int row0 = u.pm * BM + wr * 64 + fr, colb = u.pn * BM + wc * 32 + 8 * fq;
        f32x4 bv[2][2];
        if (GLU) {
#pragma unroll
            for (int bj = 0; bj < 2; ++bj) { bv[bj][0] = *(const f32x4*)(bias + colb + bj * HALF); bv[bj][1] = *(const f32x4*)(bias + colb + bj * HALF + 4); }
        }
        constexpr int MB = GLU ? 2 : 4;
#pragma unroll
        for (int ai = 0; ai < 2; ++ai)
#pragma unroll
            for (int mb = 0; mb < 4; mb += MB) {
                f32x4 x0[MB][2], x1[MB][2]; u32x4 yv[MB][2];
#pragma unroll
                for (int mm = 0; mm < MB; ++mm)
#pragma unroll
                    for (int bj = 0; bj < 2; ++bj) {
                        const size_t off = (size_t)(row0 + ai * HALF + (mb + mm) * 16) * 1024 + colb + bj * HALF;
                        if (GLU) { x0[mm][bj] = *(const f32x4*)(xin + off); x1[mm][bj] = *(const f32x4*)(xin + off + 4); yv[mm][bj] = *(const u32x4*)(Yg + off); }
                        else { yv[mm][bj] = *(const u32x4*)(xb + off); }
                    }
                asm volatile("" ::: "memory");
#pragma unroll
                for (int mm = 0; mm < MB; ++mm) {
                    const int m = mb + mm, r = row0 + ai * HALF + m * 16; float ss = 0.f;
#pragma unroll
                    for (int bj = 0; bj < 2; ++bj) {
                        const size_t off = (size_t)r * 1024 + colb + bj * HALF;
                        f32x4 v0 = acc[ai][bj][m][0], v1 = acc[ai][bj][m][1], xa, xc; const u32x4 y = yv[mm][bj];
                        if (GLU) {
                            const f32x4 b0 = bv[bj][0], b1 = bv[bj][1];
                            v0[0] = bf_lo(y[0]) * mk::fast_sigmoid(v0[0] + b0[0]); v0[1] = bf_hi(y[0]) * mk::fast_sigmoid(v0[1] + b0[1]);
                            v0[2] = bf_lo(y[1]) * mk::fast_sigmoid(v0[2] + b0[2]); v0[3] = bf_hi(y[1]) * mk::fast_sigmoid(v0[3] + b0[3]);
                            v1[0] = bf_lo(y[2]) * mk::fast_sigmoid(v1[0] + b1[0]); v1[1] = bf_hi(y[2]) * mk::fast_sigmoid(v1[1] + b1[1]);
                            v1[2] = bf_lo(y[3]) * mk::fast_sigmoid(v1[2] + b1[2]); v1[3] = bf_hi(y[3]) * mk::fast_sigmoid(v1[3] + b1[3]);
                            xa = x0[mm][bj]; xc = x1[mm][bj];
                        } else {
                            xa = (f32x4){bf_lo(y[0]), bf_hi(y[0]), bf_lo(y[1]), bf_hi(y[1])}; xc = (f32x4){bf_lo(y[2]), bf_hi(y[2]), bf_lo(y[3]), bf_hi(y[3])};
                        }
                        const f32x4 o0 = xa + v0, o1 = xc + v1;
                        u32x4 w; w.x = pk2(o0[0], o0[1]); w.y = pk2(o0[2], o0[3]); w.z = pk2(o1[0], o1[1]); w.w = pk2(o1[2], o1[3]);
                        *(u32x4*)(xb + off) = w;
                        ss += (o0[0] * o0[0] + o0[1] * o0[1]) + (o0[2] * o0[2] + o0[3] * o0[3]) + (o1[0] * o1[0] + o1[1] * o1[1]) + (o1[2] * o1[2] + o1[3] * o1[3]);
                    }
                    ss += __shfl_xor(ss, 16); ss += __shfl_xor(ss, 32);
                    if (fq == 0) part[(size_t)r * 16 + u.pn * 4 + wc] = ss;
                }
            }
    }
};
__device__ __forceinline__ void rowscale_prefetch(const float* part, const Unit& u, int wid, PG8_LAS unsigned char* ldsx) {
    const float* src = part + (size_t)u.pm * BM * 16 + (size_t)wid * 512 + (threadIdx.x & 63) * 4;
#pragma unroll
    for (int j = 0; j < 2; ++j) __builtin_amdgcn_global_load_lds((const unsigned*)(src + j * 256), (PG8_LAS unsigned*)(ldsx + (wid * 2 + j) * 1024), 16, 0, 0);
}
__device__ __forceinline__ void tile_rstd(const PG8_LAS unsigned char* ldsx, int wr, int fr, float (&rs)[2][4]) {
#pragma unroll
    for (int ai = 0; ai < 2; ++ai)
#pragma unroll
        for (int m = 0; m < 4; ++m) { const PG8_LAS f32x4* p = (const PG8_LAS f32x4*)(ldsx + (ai * HALF + wr * 64 + m * 16 + fr) * 64);
            const f32x4 a = p[0], b = p[1], c = p[2], d = p[3]; const f32x4 s = (a + b) + (c + d);
            rs[ai][m] = rsqrtf(((s[0] + s[1]) + (s[2] + s[3])) * (1.0f / 1024.0f) + mk::EPS); }
}
struct EpiGateUp {
    static constexpr bool PERM = true, AFTER_DRAIN = false;
    bf16_t* H; const float* part; unsigned skip; const PG8_LAS unsigned char* ldsx;
    __device__ __forceinline__ void prefetch(const Unit& u, int wid, PG8_LAS unsigned char* lx) const { rowscale_prefetch(part, u, wid, lx); }
    __device__ __forceinline__ void operator()(const f32x4 (&acc)[2][2][4][2], const Unit& u, int wr, int wc, int fr, int fq) const {
        if (skip & 16u) { asm volatile("" :: "v"(acc[0][0][0][0][0]), "v"(acc[1][1][3][1][3])); return; }
        const int row0 = u.pm * BM + wr * 64 + fr, col = u.pn * HALF + wc * 32 + 8 * fq;
        float rsv[2][4]; tile_rstd(ldsx, wr, fr, rsv);
        if (skip & 64u) {
#pragma unroll
            for (int ai = 0; ai < 2; ++ai)
#pragma unroll
                for (int m = 0; m < 4; ++m) { const int r = row0 + ai * HALF + m * 16;
                    u32x4 w; w.x = pk2(acc[ai][0][m][0][0], acc[ai][0][m][0][1]); w.y = pk2(acc[ai][0][m][0][2], acc[ai][0][m][0][3]); w.z = pk2(acc[ai][1][m][1][0], acc[ai][1][m][1][1]); w.w = pk2(acc[ai][1][m][1][2], rsv[ai][m]);
                    *(u32x4*)(H + (size_t)r * mk::FF + col) = w; }
            return; }
#pragma unroll
        for (int ai = 0; ai < 2; ++ai)
#pragma unroll
            for (int m = 0; m < 4; ++m) {
                const int r = row0 + ai * HALF + m * 16; const float rs = rsv[ai][m];
                float h[8];
#pragma unroll
                for (int n = 0; n < 2; ++n)
#pragma unroll
                    for (int j = 0; j < 4; ++j) h[4 * n + j] = mk::fast_silu(acc[ai][0][m][n][j] * rs) * (acc[ai][1][m][n][j] * rs);
                u32x4 w; w.x = pk2(h[0], h[1]); w.y = pk2(h[2], h[3]); w.z = pk2(h[4], h[5]); w.w = pk2(h[6], h[7]);
                if (skip & 32u) asm volatile("" :: "v"(w.x), "v"(w.y), "v"(w.z), "v"(w.w)); else
                *(u32x4*)(H + (size_t)r * mk::FF + col) = w;
            }
    }
};
struct EpiProj {
    static constexpr bool PERM = true, AFTER_DRAIN = false;
    bf16_t *Q, *K, *VD, *SG; const float* part; const PG8_LAS unsigned char* ldsx;
    __device__ __forceinline__ void prefetch(const Unit& u, int wid, PG8_LAS unsigned char* lx) const { rowscale_prefetch(part, u, wid, lx); }
    __device__ __forceinline__ void operator()(const f32x4 (&acc)[2][2][4][2], const Unit& u, int wr, int wc, int fr, int fq) const {
        const int row0 = u.pm * BM + wr * 64 + fr, cin = wc * 32 + 8 * fq;
        float rsv[2][4]; tile_rstd(ldsx, wr, fr, rsv);
        if (u.pn < 8) {
            const int h = u.pn & 3; bf16_t* dst = (u.pn < 4 ? Q : K) + h * 256 + cin; const float sc0 = u.pn < 4 ? 1.0f : 0.0625f;
            float invf[8];
#pragma unroll
            for (int j = 0; j < 8; ++j) invf[j] = exp2f(-((float)(cin + j) * (1.0f / 127.0f)) * mk::LOG2_ROPE);
#pragma unroll
            for (int ai = 0; ai < 2; ++ai)
#pragma unroll
                for (int m = 0; m < 4; ++m) {
                    const int r = row0 + ai * HALF + m * 16; const float sc = rsv[ai][m] * sc0, pos = (float)(r & (mk::L - 1));
                    float o1[8], o2[8];
#pragma unroll
                    for (int n = 0; n < 2; ++n)
#pragma unroll
                        for (int j = 0; j < 4; ++j) { float sn, cs; mk::sincos_rev(pos * invf[4 * n + j], sn, cs);
                            const float t1 = acc[ai][0][m][n][j] * sc, t2 = acc[ai][1][m][n][j] * sc;
                            o1[4 * n + j] = t1 * cs - t2 * sn; o2[4 * n + j] = t1 * sn + t2 * cs; }
                    u32x4 w1, w2; w1.x = pk2(o1[0], o1[1]); w1.y = pk2(o1[2], o1[3]); w1.z = pk2(o1[4], o1[5]); w1.w = pk2(o1[6], o1[7]);
                    w2.x = pk2(o2[0], o2[1]); w2.y = pk2(o2[2], o2[3]); w2.z = pk2(o2[4], o2[5]); w2.w = pk2(o2[6], o2[7]);
                    *(u32x4*)(dst + (size_t)r * 1024) = w1; *(u32x4*)(dst + (size_t)r * 1024 + 128) = w2;
                }
        } else {
            const bool isv = u.pn < 16; const int ct = isv ? u.pn - 8 : u.pn - 16;
            bf16_t* dst = (isv ? VD : SG) + ct * 256 + cin; const float lg = mk::log2_gamma(ct >> 1);
#pragma unroll
            for (int ai = 0; ai < 2; ++ai)
#pragma unroll
                for (int m = 0; m < 4; ++m) {
                    const int r = row0 + ai * HALF + m * 16; const float rs = rsv[ai][m];
                    const float vs = rs * exp2f(lg * (float)(63 - (r & 63)));
#pragma unroll
                    for (int bj = 0; bj < 2; ++bj) {
                        float o[8];
#pragma unroll
                        for (int n = 0; n < 2; ++n)
#pragma unroll
                            for (int j = 0; j < 4; ++j) { const float a = acc[ai][bj][m][n][j]; o[4 * n + j] = isv ? a * vs : mk::fast_silu(a * rs); }
                        u32x4 w; w.x = pk2(o[0], o[1]); w.y = pk2(o[2], o[3]); w.z = pk2(o[4], o[5]); w.w = pk2(o[6], o[7]);
                        *(u32x4*)(dst + (size_t)r * 2048 + bj * HALF) = w;
                    }
                }
        }
    }
};
}
namespace mk {
#define MFMA16(a, b, c) __builtin_amdgcn_mfma_f32_16x16x32_bf16((a), (b), (c), 0, 0, 0)
#define LDS_WAIT() asm volatile("s_waitcnt lgkmcnt(0)" ::: "memory")

struct Frame {
    LAS unsigned char* lds;
    int tid, lane, wave, G;
    const float* const* in; float* out; unsigned char* ws;
    TS_MEMBERS
    unsigned pflags;
    bf16* pp;
};

__device__ __forceinline__ void transpose_item(const float* W, int K, int N, const float* gain, bf16* WT, int mode, int item, LAS float* scr, int lane) {
    const int nblk = N / 32, kb = item / nblk, nb = item % nblk, k0 = 64 * kb, n0 = 32 * nb;
    f32x4 v[8];
#pragma unroll
    for (int i = 0; i < 8; ++i) v[i] = *(const f32x4*)(W + (size_t)(k0 + (lane >> 3) + 8 * i) * N + n0 + 4 * (lane & 7));
#pragma unroll
    for (int i = 0; i < 8; ++i) { const int kk = (lane >> 3) + 8 * i; const float gs = gain ? gain[k0 + kk] : 1.0f; LAS float* d = scr + kk * 33 + 4 * (lane & 7);
        d[0] = v[i][0] * gs; d[1] = v[i][1] * gs; d[2] = v[i][2] * gs; d[3] = v[i][3] * gs; }
    LDS_WAIT(); asm volatile("" ::: "memory");
    const int c = lane & 7;
    const int r0 = (mode == 0) ? n0 : ((n0 >> 7) * 256 + (mode == 2 ? 128 : 0) + (n0 & 127));
#pragma unroll
    for (int j = 0; j < 4; ++j) { const int n = (lane >> 3) + 8 * j; const LAS float* s = scr + (8 * c) * 33 + n;
        u32x4 o; o.x = pk2(s[0 * 33], s[1 * 33]); o.y = pk2(s[2 * 33], s[3 * 33]); o.z = pk2(s[4 * 33], s[5 * 33]); o.w = pk2(s[6 * 33], s[7 * 33]);
        *(u32x4*)(WT + (size_t)(r0 + n) * K + k0 + 8 * c) = o; }
    LDS_WAIT(); asm volatile("" ::: "memory");
}
__device__ __forceinline__ void p0_weights(Frame& F) {
    LAS float* scr = (LAS float*)(F.lds + F.wave * 8448);
    const int gw = blockIdx.x * NWAVES + F.wave, NGW = F.G * NWAVES;
    constexpr int I_GLU = 16 * 32, I_GU = 16 * 88, I_DN = 44 * 32, I_QK = 16 * 192, I_WO = 32 * 32;
    constexpr int NITEMS = I_GLU + 2 * (2 * I_GU + I_DN) + I_QK + I_WO;
    unsigned char* ws = F.ws;
    for (int it = gw; it < NITEMS; it += NGW) {
        int r = it;
        if (r < I_GLU) { transpose_item(F.in[10], D, D, nullptr, (bf16*)(ws + WS_WGLU), 0, r, scr, F.lane); continue; } r -= I_GLU;
        bool done = false;
#pragma unroll
        for (int l = 0; l < 2; ++l) {
            if (done) break;
            bf16* gu = (bf16*)(ws + (l ? WS_WGU1 : WS_WGU0)); bf16* dn = (bf16*)(ws + (l ? WS_WDN1 : WS_WDN0));
            if (r < I_GU) { transpose_item(F.in[17] + (size_t)l * D * FF, D, FF, F.in[16] + l * D, gu, 1, r, scr, F.lane); done = true; break; } r -= I_GU;
            if (r < I_GU) { transpose_item(F.in[18] + (size_t)l * D * FF, D, FF, F.in[16] + l * D, gu, 2, r, scr, F.lane); done = true; break; } r -= I_GU;
            if (r < I_DN) { transpose_item(F.in[19] + (size_t)l * FF * D, FF, D, nullptr, dn, 0, r, scr, F.lane); done = true; break; } r -= I_DN;
        }
        if (done) continue;
        if (r < I_QK) { transpose_item(F.in[13], D, PW, F.in[12], (bf16*)(ws + WS_WQKVG), 0, r, scr, F.lane); continue; } r -= I_QK;
        transpose_item(F.in[15], 2048, D, nullptr, (bf16*)(ws + WS_WO), 0, r, scr, F.lane);
    }
}

__device__ __forceinline__ void p0_s5consts(Frame& F) {
    LAS float* ap = (LAS float*)(F.lds + 70000 - 70000 % 16);
    LAS float* bb = ap + 17 * 64 * 2;
    LAS float* cc = bb + 64 * 16 * 2;
    for (int item = blockIdx.x; item < 256; item += F.G) {
        const int g = item >> 2, part = item & 3, tid = F.tid;
        __syncthreads();
        if (tid < 64) {
            const int p = tid; const float lr = F.in[2][g * 64 + p], li = F.in[3][g * 64 + p], dt = expf(F.in[4][g]);
#pragma unroll 1
            for (int l = 0; l <= 16; ++l) { const float er = expf(lr * dt * (float)l); float sn, cs; sincos_rev(li * dt * (float)l, sn, cs); ap[(l * 64 + p) * 2] = er * cs; ap[(l * 64 + p) * 2 + 1] = er * sn; }
            const float er = expf(lr * dt); float sn, cs; sincos_rev(li * dt, sn, cs);
            const float ar = er * cs, ai = er * sn, nr = ar - 1.0f, ni = ai, den = lr * lr + li * li;
            const float fr = (nr * lr + ni * li) / den, fi = (ni * lr - nr * li) / den;
#pragma unroll 1
            for (int m = 0; m < 16; ++m) { const float br = F.in[5][(g * 64 + p) * 16 + m], bi = F.in[6][(g * 64 + p) * 16 + m]; bb[(p * 16 + m) * 2] = fr * br - fi * bi; bb[(p * 16 + m) * 2 + 1] = fr * bi + fi * br; }
        }
        for (int e = tid; e < 1024; e += NTHREADS) { cc[e * 2] = F.in[7][g * 1024 + e]; cc[e * 2 + 1] = F.in[8][g * 1024 + e]; }
        __syncthreads();
        unsigned char* sc = F.ws + WS_S5C + (size_t)g * S5C_STRIDE;
        bf16* tiles = (bf16*)(sc + S5C_TILES); bf16* win = (bf16*)(sc + S5C_WIN); bf16* wout = (bf16*)(sc + S5C_WOUT); float* a16 = (float*)(sc + S5C_A16);
        for (int e = tid; e < 1024; e += NTHREADS) {
            const int l = 4 * part + (e >> 8), n = (e >> 4) & 15, m = e & 15; float s = 0.f;
            for (int p = 0; p < 64; ++p) { const float ar = ap[(l * 64 + p) * 2], ai = ap[(l * 64 + p) * 2 + 1], br = bb[(p * 16 + m) * 2], bi = bb[(p * 16 + m) * 2 + 1];
                const float tr = ar * br - ai * bi, ti = ar * bi + ai * br; s += cc[(n * 64 + p) * 2] * tr - cc[(n * 64 + p) * 2 + 1] * ti; }
            if (l == 0 && n == m) s += F.in[9][g * 16 + n];
            const bf16 v = (bf16)(pk2(s, 0.f) & 0xffffu);
            tiles[(l * 16 + n) * 32 + m] = v;
            if (l + 1 <= 15) tiles[((l + 1) * 16 + n) * 32 + 16 + m] = v;
            if (l == 0) tiles[(0 * 16 + n) * 32 + 16 + m] = 0;
        }
        for (int e = tid; e < 8192; e += NTHREADS) {
            const int q = e >> 6, j = 4 * part + ((e >> 4) & 3), m = e & 15, p = q & 63, l = 15 - j;
            const float ar = ap[(l * 64 + p) * 2], ai = ap[(l * 64 + p) * 2 + 1], br = bb[(p * 16 + m) * 2], bi = bb[(p * 16 + m) * 2 + 1];
            const float v = q < 64 ? ar * br - ai * bi : ar * bi + ai * br;
            win[q * 256 + j * 16 + m] = (bf16)(pk2(v, 0.f) & 0xffffu);
        }
        for (int e = tid; e < 8192; e += NTHREADS) {
            const int i = 4 * part + (e >> 11), n = (e >> 7) & 15, q = e & 127, p = q & 63, l = i + 1;
            const float ar = ap[(l * 64 + p) * 2], ai = ap[(l * 64 + p) * 2 + 1], cr = cc[(n * 64 + p) * 2], ci = cc[(n * 64 + p) * 2 + 1];
            const float v = q < 64 ? cr * ar - ci * ai : -(cr * ai + ci * ar);
            wout[(i * 16 + n) * 128 + q] = (bf16)(pk2(v, 0.f) & 0xffffu);
        }
        if (part == 0 && tid < 64) { a16[tid * 2] = ap[(16 * 64 + tid) * 2]; a16[tid * 2 + 1] = ap[(16 * 64 + tid) * 2 + 1]; }
    }
}

__device__ __forceinline__ void rows_to_u(Frame& F, const float* x, const float* g, bf16* dst) {
    const int gw = blockIdx.x * NWAVES + F.wave, NGW = F.G * NWAVES, lane = F.lane;
    for (int m = gw; m < T; m += NGW) {
        const f32x4* xr = (const f32x4*)(x + (size_t)m * D) + lane;
        f32x4 v[4]; float s = 0.f;
#pragma unroll
        for (int j = 0; j < 4; ++j) { v[j] = xr[64 * j]; s += (v[j][0] * v[j][0] + v[j][1] * v[j][1]) + (v[j][2] * v[j][2] + v[j][3] * v[j][3]); }
        s = wave_sum(s);
        const float rs = rsqrtf(s * (1.0f / D) + EPS);
        u32x2* o = (u32x2*)(dst + (size_t)m * D) + lane;
#pragma unroll
        for (int j = 0; j < 4; ++j) { const f32x4 gv = *((const f32x4*)g + lane + 64 * j); const f32x4 y = v[j] * rs * gv; u32x2 w; w.x = pk2(y[0], y[1]); w.y = pk2(y[2], y[3]); o[64 * j] = w; }
    }
}
__device__ __forceinline__ void rows_final(Frame& F, const bf16* xb, const float* g, float* dst) {
    const int gw = blockIdx.x * NWAVES + F.wave, NGW = F.G * NWAVES, lane = F.lane;
    for (int m = gw; m < T; m += NGW) {
        const u32x4* xr = (const u32x4*)(xb + (size_t)m * D) + lane;
        float v[2][8]; float s = 0.f;
#pragma unroll
        for (int j = 0; j < 2; ++j) { const u32x4 u = xr[64 * j];
            v[j][0] = bf_lo(u.x); v[j][1] = bf_hi(u.x); v[j][2] = bf_lo(u.y); v[j][3] = bf_hi(u.y); v[j][4] = bf_lo(u.z); v[j][5] = bf_hi(u.z); v[j][6] = bf_lo(u.w); v[j][7] = bf_hi(u.w);
#pragma unroll
            for (int e = 0; e < 8; ++e) s += v[j][e] * v[j][e]; }
        s = wave_sum(s);
        const float rs = rsqrtf(s * (1.0f / D) + EPS);
#pragma unroll
        for (int j = 0; j < 2; ++j) { const f32x4 g0 = *(const f32x4*)(g + 8 * lane + 512 * j), g1 = *(const f32x4*)(g + 8 * lane + 512 * j + 4);
            f32x4 o0, o1;
#pragma unroll
            for (int e = 0; e < 4; ++e) { o0[e] = v[j][e] * rs * g0[e]; o1[e] = v[j][4 + e] * rs * g1[e]; }
            float* op = dst + (size_t)m * D + 8 * lane + 512 * j; *(f32x4*)op = o0; *(f32x4*)(op + 4) = o1; }
    }
}

__device__ __forceinline__ void p1_s5(Frame& F) {
    constexpr int UBB = 16896, ZB_OFF = 2 * UBB, XS_OFF = ZB_OFF + 16896, YB_OFF = XS_OFF + 8704;
    const int tid = F.tid, w = F.wave, lane = F.lane, lr = lane & 15, lg = lane >> 4;
    for (int unit = blockIdx.x; unit < 256; unit += F.G) {
        const int xcd = unit & 7, slot = unit >> 3, g = 8 * xcd + (slot & 7), b = slot >> 3;
        const unsigned char* sc = F.ws + WS_S5C + (size_t)g * S5C_STRIDE;
        const bf16* tiles = (const bf16*)(sc + S5C_TILES); const bf16* win = (const bf16*)(sc + S5C_WIN); const bf16* wout = (const bf16*)(sc + S5C_WOUT); const float* a16 = (const float*)(sc + S5C_A16);
        const bf16* Ub = (const bf16*)(F.ws + WS_U) + (size_t)b * L * D + g * 16;
        bf16* Yb = (bf16*)(F.ws + WS_YG) + (size_t)b * L * D + g * 16;
        const int ilo = w, ihi = 15 - w;
        bf16x8 WinF[8], WoF[2][4], Tlo[4], Thi[8];
#pragma unroll
        for (int ks = 0; ks < 8; ++ks) WinF[ks] = *(const bf16x8*)(win + (16 * w + lr) * 256 + 32 * ks + 8 * lg);
#pragma unroll
        for (int ks = 0; ks < 4; ++ks) { WoF[0][ks] = *(const bf16x8*)(wout + (ilo * 16 + lr) * 128 + 32 * ks + 8 * lg); WoF[1][ks] = *(const bf16x8*)(wout + (ihi * 16 + lr) * 128 + 32 * ks + 8 * lg); }
#pragma unroll
        for (int jp = 0; jp < 4; ++jp) { const int e = ilo - 2 * jp; const bf16x8 t = *(const bf16x8*)(tiles + ((e < 0 ? 0 : e) * 16 + lr) * 32 + 8 * lg); Tlo[jp] = e < 0 ? (bf16x8){0, 0, 0, 0, 0, 0, 0, 0} : t; }
#pragma unroll
        for (int jp = 0; jp < 8; ++jp) { const int e = ihi - 2 * jp; const bf16x8 t = *(const bf16x8*)(tiles + ((e < 0 ? 0 : e) * 16 + lr) * 32 + 8 * lg); Thi[jp] = e < 0 ? (bf16x8){0, 0, 0, 0, 0, 0, 0, 0} : t; }
        const float a16r = a16[(lane) * 2], a16i = a16[(lane) * 2 + 1];
        float xr = 0.f, xi = 0.f;
        u32x4 ur0, ur1;
        { const bf16* up = Ub + (size_t)tid * D; ur0 = *(const u32x4*)up; ur1 = *(const u32x4*)(up + 8); }
        { LAS unsigned char* ub = F.lds + (tid >> 4) * 528 + (tid & 15) * 32; *(LAS u32x4*)ub = ur0; *(LAS u32x4*)(ub + 16) = ur1; }
        __syncthreads();
#define P1_FLUSH(sp) do { _Pragma("unroll") for (int j_ = 0; j_ < 2; ++j_) { const int tk_ = (tid >> 1) + 256 * j_; \
            const LAS unsigned char* yp_ = F.lds + YB_OFF + (tk_ >> 4) * 520 + (tk_ & 15) * 32 + (tid & 1) * 16; \
            const u32x2 lo_ = *(const LAS u32x2*)yp_, hi_ = *(const LAS u32x2*)(yp_ + 8); \
            *(u32x4*)(Yb + (size_t)((sp) * 512 + tk_) * D + (tid & 1) * 8) = (u32x4){lo_.x, lo_.y, hi_.x, hi_.y}; } } while (0)
#pragma unroll 1
        for (int s = 0; s < 16; ++s) {
            LAS unsigned char* UBc = F.lds + (s & 1) * UBB; LAS unsigned char* UBn = F.lds + ((s + 1) & 1) * UBB;
            if (s + 1 < 16 && !(F.pflags & 0x100u)) { const bf16* up = Ub + (size_t)((s + 1) * 512 + tid) * D; ur0 = *(const u32x4*)up; ur1 = *(const u32x4*)(up + 8); }
            {
                f32x4 z0 = {0.f, 0.f, 0.f, 0.f}, z1 = z0;
#pragma unroll
                for (int ks = 0; ks < 8; ++ks) {
                    const LAS unsigned char* a = UBc + lr * 528 + (2 * ks + (lg >> 1)) * 32 + (lg & 1) * 16;
                    const bf16x8 u0 = *(const LAS bf16x8*)a, u1 = *(const LAS bf16x8*)(a + 16 * 528);
                    z0 = MFMA16(WinF[ks], u0, z0); z1 = MFMA16(WinF[ks], u1, z1);
                }
                LAS unsigned char* zb = F.lds + ZB_OFF + lr * 528 + (16 * w + 4 * lg) * 4;
                *(LAS f32x4*)zb = z0; *(LAS f32x4*)(zb + 16 * 528) = z1;
            }
            __syncthreads();
            if (w == 0 && !(F.pflags & 0x400u)) {
                const LAS float* zf = (const LAS float*)(F.lds + ZB_OFF); LAS bf16* xs = (LAS bf16*)(F.lds + XS_OFF);
#pragma unroll
                for (int hc = 0; hc < 2; ++hc) {
                    float zr[16], zi[16];
#pragma unroll
                    for (int c = 0; c < 16; ++c) { zr[c] = zf[(16 * hc + c) * 132 + lane]; zi[c] = zf[(16 * hc + c) * 132 + 64 + lane]; }
#pragma unroll
                    for (int c = 0; c < 16; ++c) {
                        const unsigned pk = pk2(xr, xi);
                        xs[(16 * hc + c) * 136 + lane] = (bf16)(pk & 0xffffu); xs[(16 * hc + c) * 136 + 64 + lane] = (bf16)(pk >> 16);
                        const float nr = a16r * xr - a16i * xi + zr[c], ni = a16r * xi + a16i * xr + zi[c]; xr = nr; xi = ni;
                    }
                }
            }
            if (s + 1 < 16) { LAS unsigned char* ub = UBn + (tid >> 4) * 528 + (tid & 15) * 32; *(LAS u32x4*)ub = ur0; *(LAS u32x4*)(ub + 16) = ur1; }
            if (s > 0 && !(F.pflags & 0x200u)) P1_FLUSH(s - 1);
            __syncthreads();
#pragma unroll
            for (int ii = 0; ii < 2; ++ii) {
                const int i = ii ? ihi : ilo;
                f32x4 a0 = {0.f, 0.f, 0.f, 0.f}, a1 = a0;
#pragma unroll
                for (int jp = 0; jp < (ii ? 8 : 4); ++jp) {
                    if (jp <= (i >> 1)) {
                        const LAS unsigned char* a = UBc + lr * 528 + (2 * jp + (lg >> 1)) * 32 + (lg & 1) * 16;
                        const bf16x8 u0 = *(const LAS bf16x8*)a, u1 = *(const LAS bf16x8*)(a + 16 * 528);
                        const bf16x8 tt = ii ? Thi[jp] : Tlo[jp];
                        a0 = MFMA16(tt, u0, a0); a1 = MFMA16(tt, u1, a1);
                    }
                }
#pragma unroll
                for (int ks = 0; ks < 4; ++ks) {
                    const LAS unsigned char* a = F.lds + XS_OFF + lr * 272 + (32 * ks + 8 * lg) * 2;
                    const bf16x8 x0 = *(const LAS bf16x8*)a, x1 = *(const LAS bf16x8*)(a + 16 * 272);
                    a0 = MFMA16(WoF[ii][ks], x0, a0); a1 = MFMA16(WoF[ii][ks], x1, a1);
                }
                { u32x2 o; o.x = pk2(gelu_tanh(a0[0]), gelu_tanh(a0[1])); o.y = pk2(gelu_tanh(a0[2]), gelu_tanh(a0[3]));
                  *(LAS u32x2*)(F.lds + YB_OFF + lr * 520 + i * 32 + lg * 8) = o; }
                { u32x2 o; o.x = pk2(gelu_tanh(a1[0]), gelu_tanh(a1[1])); o.y = pk2(gelu_tanh(a1[2]), gelu_tanh(a1[3]));
                  *(LAS u32x2*)(F.lds + YB_OFF + (16 + lr) * 520 + i * 32 + lg * 8) = o; }
            }
        }
        __syncthreads();
        P1_FLUSH(15);
#undef P1_FLUSH
        __syncthreads();
    }
}

__device__ __forceinline__ void p6_scores(Frame& F) {
    const int w = F.wave, lane = F.lane, lr = lane & 15, lg = lane >> 4, it = w & 3, jh = w >> 2;
    const bf16* Q = (const bf16*)(F.ws + WS_Q); const bf16* K = (const bf16*)(F.ws + WS_K); bf16* PP = F.pp;
    for (int unit = blockIdx.x; unit < 2048; unit += F.G) {
        const int c = unit & 127, bh = unit >> 7, b = bh >> 2, h = bh & 3; const float lg2 = log2_gamma(h);
        const size_t tokbase = (size_t)b * L + c * 64;
        bf16x8 qf[8];
#pragma unroll
        for (int ks = 0; ks < 8; ++ks) qf[ks] = *(const bf16x8*)(Q + (tokbase + 16 * it + lr) * 1024 + 256 * h + 32 * ks + 8 * lg);
#pragma unroll
        for (int jt = 0; jt < 2; ++jt) {
            f32x4 acc = {0.f, 0.f, 0.f, 0.f};
#pragma unroll
            for (int ks = 0; ks < 8; ++ks) { const bf16x8 kf = *(const bf16x8*)(K + (tokbase + 32 * jh + 16 * jt + lr) * 1024 + 256 * h + 32 * ks + 8 * lg); acc = MFMA16(kf, qf[ks], acc); }
            const int i = 16 * it + lr, j0 = 32 * jh + 16 * jt + 4 * lg; float o[4];
#pragma unroll
            for (int r = 0; r < 4; ++r) { const int j = j0 + r; const int ex = (j <= i) ? -64 : 2 * (j - i) - 64; o[r] = acc[r] * exp2f(lg2 * (float)ex); }
            u32x2 wv; wv.x = pk2(o[0], o[1]); wv.y = pk2(o[2], o[3]);
            *(u32x2*)(PP + (size_t)unit * 4096 + i * 64 + j0) = wv;
        }
    }
}

#define TR1(d, addr, off) asm volatile("ds_read_b64_tr_b16 %0, %1 offset:%2" : "=v"(d) : "v"(addr), "i"(off) : "memory")
#define TRWAIT8(a, b, c, d, e, f, g, h) asm volatile("s_waitcnt lgkmcnt(0)" : "+v"(a), "+v"(b), "+v"(c), "+v"(d), "+v"(e), "+v"(f), "+v"(g), "+v"(h) :: "memory")
__device__ __forceinline__ bf16x8 cat8(s16x4 lo, s16x4 hi) { return (bf16x8){lo[0], lo[1], lo[2], lo[3], hi[0], hi[1], hi[2], hi[3]}; }

#if defined(MK_TIMING) && (TGRP == 12)
#define P7A() TS(F, 1)
#define P7B() TS(F, 0)
#define P7C() TS(F, 2)
#define P7D() TS(F, 3)
#else
#define P7A() do {} while (0)
#define P7B() do {} while (0)
#define P7C() do {} while (0)
#define P7D() do {} while (0)
#endif
struct P7R { u32x4 r[10]; };

__device__ __forceinline__ void p7_ret(Frame& F, bool probe) {
    constexpr int SBB = 16896, KBB = 33792, VBB = 5120, SB_OFF = 0, KB_OFF = 2 * SBB, VB_OFF = KB_OFF + 2 * KBB;
    const int tid = F.tid, w = F.wave, lane = F.lane, lr = lane & 15, lg = lane >> 4, q_ = lr >> 2, p_ = lr & 3;
    const bool steam = w < 4; const int it = w & 3, t2 = tid & 255;
    for (int unit = blockIdx.x; unit < 256; unit += F.G) {
#ifndef P7_SPREAD
#define P7_SPREAD 0
#endif
        const int xcd = unit & 7, slot = unit >> 3;
        const int bh = P7_SPREAD == 0 ? 2 * xcd + (slot >> 4) : P7_SPREAD == 1 ? (xcd >> 1) * 4 + (slot >> 3) : (xcd >> 2) * 8 + (slot >> 2);
        const int es = P7_SPREAD == 0 ? (slot & 15) : P7_SPREAD == 1 ? (slot & 7) * 2 + (xcd & 1) : (slot & 3) * 4 + (xcd & 3);
        const int b = bh >> 2, h = bh & 3;
        const float lg2 = log2_gamma(h), cd = exp2f(64.0f * lg2), rowscale = exp2f((float)(16 * it + lr + 1) * lg2);
        const unsigned char* Qb = F.ws + WS_Q + ((size_t)b * L * 1024 + 256 * h) * 2; const unsigned qoff = ((16 * it + lr) * 1024 + 8 * lg) * 2;
        const unsigned char* Kb = F.ws + WS_K + ((size_t)b * L * 1024 + 256 * h) * 2;
        unsigned char* Vb = F.ws + WS_VD + ((size_t)b * L * 2048 + h * 512 + es * 32) * 2;
        const unsigned char* Pb = (const unsigned char*)F.pp + (size_t)bh * 128 * 4096 * 2; const unsigned poff = ((16 * it + lr) * 64 + 8 * lg) * 2;
        const unsigned koff = ((t2 >> 5) * 1024 + 8 * (t2 & 31)) * 2, voff = ((t2 >> 2) * 2048 + 8 * (t2 & 3)) * 2, ooff = ((16 * it + lr) * 2048 + 4 * lg) * 2;
        f32x4 S[4][2];
#pragma unroll
        for (int mt = 0; mt < 4; ++mt) { S[mt][0] = (f32x4){0.f, 0.f, 0.f, 0.f}; S[mt][1] = S[mt][0]; }
        P7R RA, RB;
        unsigned pfa = 0u, pfb = 0u;
        const bool pfwave = (w == 0) || (w == 4) || (w == 5);
        const unsigned pfoff = (w == 5) ? (unsigned)((4 * es + (lane & 3)) * 128) : (unsigned)((4 * es + ((lane & 15) >> 2)) * 2048 + (lane & 3) * 128);
        const unsigned char* pfbase = (w == 0) ? Kb : (w == 4 ? Qb : Pb); const size_t pfstride = (w == 5) ? 8192 : 131072;
#define P7_FARPF(pf, c_) do { asm volatile("" :: "v"(pf)); if (pfwave && (c_) + 6 < 128) pf = *(const volatile unsigned*)(pfbase + (size_t)((c_) + 6) * pfstride + pfoff); } while (0)
#define P7_LOADS(R, c_) do { const unsigned char* kc_ = Kb + (size_t)(c_) * 131072; _Pragma("unroll") for (int i_ = 0; i_ < 8; ++i_) R.r[i_] = *(const u32x4*)(kc_ + koff + i_ * 16384); \
            R.r[8] = *(const u32x4*)(Vb + (size_t)(c_) * 262144 + voff); } while (0)
#define P7_STAGE(R, buf_) do { _Pragma("unroll") for (int i_ = 0; i_ < 8; ++i_) { const int id_ = t2 + 256 * i_; *(LAS u32x4*)(F.lds + KB_OFF + (buf_) * KBB + (id_ >> 5) * 528 + (id_ & 31) * 16) = R.r[i_]; } \
            *(LAS u32x4*)(F.lds + VB_OFF + (buf_) * VBB + (t2 >> 2) * 80 + (t2 & 3) * 16) = R.r[8]; } while (0)
#define P7_LOADO(R, c_) do { const unsigned char* qc_ = Qb + (size_t)(c_) * 131072; const unsigned char* pc_ = Pb + (size_t)(c_) * 8192; \
            _Pragma("unroll") for (int ks_ = 0; ks_ < 8; ++ks_) R.r[ks_] = *(const u32x4*)(qc_ + qoff + 64 * ks_); \
            R.r[8] = *(const u32x4*)(pc_ + poff); R.r[9] = *(const u32x4*)(pc_ + poff + 64); } while (0)
#define P7_FRAG(x) __builtin_bit_cast(bf16x8, (x))
        if (steam) {
            P7_LOADS(RA, 0); P7_STAGE(RA, 0); P7_LOADS(RB, 1); P7_LOADS(RA, 2);
#pragma unroll
            for (int mt = 0; mt < 4; ++mt)
#pragma unroll
                for (int et = 0; et < 2; ++et) *(LAS u32x2*)(F.lds + SB_OFF + (16 * et + lr) * 528 + (64 * w + 16 * mt + 4 * lg) * 2) = (u32x2){0u, 0u};
        } else { P7_LOADO(RA, 0); P7_LOADO(RB, 1); }
#define P7_SSTEP(c, R, pf) do { \
            LAS unsigned char* SBc = F.lds + SB_OFF + ((c) & 1) * SBB; LAS unsigned char* KBc = F.lds + KB_OFF + ((c) & 1) * KBB; LAS unsigned char* VBc = F.lds + VB_OFF + ((c) & 1) * VBB; \
            __syncthreads(); \
            P7A(); \
            P7_FARPF(pf, c); \
            s16x4 v0, v1, v2, v3, v4, v5, v6, v7; \
            { const unsigned va = (unsigned)(uintptr_t)(VBc + (8 * lg + q_) * 80 + (4 * p_) * 2); \
              TR1(v0, va, 0); TR1(v1, va, 4 * 80); TR1(v2, va, 32); TR1(v3, va, 4 * 80 + 32); TR1(v4, va, 32 * 80); TR1(v5, va, 36 * 80); TR1(v6, va, 32 * 80 + 32); TR1(v7, va, 36 * 80 + 32); } \
                const unsigned ka = (unsigned)(uintptr_t)(KBc + (8 * lg + q_) * 528 + (64 * w + 4 * p_) * 2); \
                s16x4 k0, k1, k2, k3, k4, k5, k6, k7; \
                TR1(k0, ka, 0); TR1(k1, ka, 4 * 528); TR1(k2, ka, 32); TR1(k3, ka, 4 * 528 + 32); TR1(k4, ka, 64); TR1(k5, ka, 4 * 528 + 64); TR1(k6, ka, 96); TR1(k7, ka, 4 * 528 + 96); \
                TRWAIT8(v0, v1, v2, v3, v4, v5, v6, v7); TRWAIT8(k0, k1, k2, k3, k4, k5, k6, k7); \
                const bf16x8 vt00 = cat8(v0, v1), vt10 = cat8(v2, v3), vt01 = cat8(v4, v5), vt11 = cat8(v6, v7);     \
                const bf16x8 kt00 = cat8(k0, k1), kt10 = cat8(k2, k3), kt20 = cat8(k4, k5), kt30 = cat8(k6, k7);     \
                s16x4 j0, j1, j2, j3, j4, j5, j6, j7; \
                TR1(j0, ka, 32 * 528); TR1(j1, ka, 36 * 528); TR1(j2, ka, 32 * 528 + 32); TR1(j3, ka, 36 * 528 + 32); TR1(j4, ka, 32 * 528 + 64); TR1(j5, ka, 36 * 528 + 64); TR1(j6, ka, 32 * 528 + 96); TR1(j7, ka, 36 * 528 + 96); \
                _Pragma("unroll") for (int mt = 0; mt < 4; ++mt) { S[mt][0] = S[mt][0] * cd; S[mt][1] = S[mt][1] * cd; } \
                S[0][0] = MFMA16(kt00, vt00, S[0][0]); S[0][1] = MFMA16(kt00, vt10, S[0][1]); S[1][0] = MFMA16(kt10, vt00, S[1][0]); S[1][1] = MFMA16(kt10, vt10, S[1][1]); \
                S[2][0] = MFMA16(kt20, vt00, S[2][0]); S[2][1] = MFMA16(kt20, vt10, S[2][1]); S[3][0] = MFMA16(kt30, vt00, S[3][0]); S[3][1] = MFMA16(kt30, vt10, S[3][1]); \
                TRWAIT8(j0, j1, j2, j3, j4, j5, j6, j7); \
                const bf16x8 kt01 = cat8(j0, j1), kt11 = cat8(j2, j3), kt21 = cat8(j4, j5), kt31 = cat8(j6, j7); \
                S[0][0] = MFMA16(kt01, vt01, S[0][0]); S[0][1] = MFMA16(kt01, vt11, S[0][1]); S[1][0] = MFMA16(kt11, vt01, S[1][0]); S[1][1] = MFMA16(kt11, vt11, S[1][1]); \
                S[2][0] = MFMA16(kt21, vt01, S[2][0]); S[2][1] = MFMA16(kt21, vt11, S[2][1]); S[3][0] = MFMA16(kt31, vt01, S[3][0]); S[3][1] = MFMA16(kt31, vt11, S[3][1]); \
                asm volatile("" :: "v"(S[0][0]), "v"(S[3][1])); P7C(); \
                  \
                if ((c) + 1 < 128) { \
                    LAS unsigned char* SBn = F.lds + SB_OFF + (((c) + 1) & 1) * SBB; \
                    _Pragma("unroll") for (int mt = 0; mt < 4; ++mt) _Pragma("unroll") for (int et = 0; et < 2; ++et) { u32x2 wv; wv.x = pk2(S[mt][et][0], S[mt][et][1]); wv.y = pk2(S[mt][et][2], S[mt][et][3]); \
                        *(LAS u32x2*)(SBn + (16 * et + lr) * 528 + (64 * w + 16 * mt + 4 * lg) * 2) = wv; } \
                    P7_STAGE(R, ((c) + 1) & 1); \
                    P7D(); \
                    if ((c) + 3 < 128) P7_LOADS(R, (c) + 3); \
                } \
                P7B(); \
        } while (0)
#define P7_OSTEP(c, R, pf) do { \
            LAS unsigned char* SBc = F.lds + SB_OFF + ((c) & 1) * SBB; LAS unsigned char* KBc = F.lds + KB_OFF + ((c) & 1) * KBB; LAS unsigned char* VBc = F.lds + VB_OFF + ((c) & 1) * VBB; \
            __syncthreads(); \
            P7A(); \
            P7_FARPF(pf, c); \
            s16x4 v0, v1, v2, v3, v4, v5, v6, v7; \
            { const unsigned va = (unsigned)(uintptr_t)(VBc + (8 * lg + q_) * 80 + (4 * p_) * 2); \
              TR1(v0, va, 0); TR1(v1, va, 4 * 80); TR1(v2, va, 32); TR1(v3, va, 4 * 80 + 32); TR1(v4, va, 32 * 80); TR1(v5, va, 36 * 80); TR1(v6, va, 32 * 80 + 32); TR1(v7, va, 36 * 80 + 32); } \
                TRWAIT8(v0, v1, v2, v3, v4, v5, v6, v7); \
                const bf16x8 vt00 = cat8(v0, v1), vt10 = cat8(v2, v3), vt01 = cat8(v4, v5), vt11 = cat8(v6, v7); \
                f32x4 a0 = {0.f, 0.f, 0.f, 0.f}, a1 = a0; \
                _Pragma("unroll") for (int kb = 0; kb < 8; kb += 2) { \
                    const bf16x8 s00 = *(const LAS bf16x8*)(SBc + lr * 528 + (32 * kb + 8 * lg) * 2), s10 = *(const LAS bf16x8*)(SBc + (16 + lr) * 528 + (32 * kb + 8 * lg) * 2); \
                    const bf16x8 s01 = *(const LAS bf16x8*)(SBc + lr * 528 + (32 * kb + 32 + 8 * lg) * 2), s11 = *(const LAS bf16x8*)(SBc + (16 + lr) * 528 + (32 * kb + 32 + 8 * lg) * 2); \
                    a0 = MFMA16(s00, P7_FRAG(R.r[kb]), a0); a1 = MFMA16(s10, P7_FRAG(R.r[kb]), a1); a0 = MFMA16(s01, P7_FRAG(R.r[kb + 1]), a0); a1 = MFMA16(s11, P7_FRAG(R.r[kb + 1]), a1); \
                    asm volatile("" ::: "memory"); } \
                a0 = MFMA16(vt00, P7_FRAG(R.r[8]), a0); a1 = MFMA16(vt10, P7_FRAG(R.r[8]), a1); a0 = MFMA16(vt01, P7_FRAG(R.r[9]), a0); a1 = MFMA16(vt11, P7_FRAG(R.r[9]), a1); \
                asm volatile("" :: "v"(a0), "v"(a1)); P7C(); \
                if ((c) + 2 < 128) P7_LOADO(R, (c) + 2); \
                P7D(); \
                u32x2 w0, w1; w0.x = pk2(a0[0] * rowscale, a0[1] * rowscale); w0.y = pk2(a0[2] * rowscale, a0[3] * rowscale); w1.x = pk2(a1[0] * rowscale, a1[1] * rowscale); w1.y = pk2(a1[2] * rowscale, a1[3] * rowscale); \
                unsigned char* op = Vb + (size_t)(c) * 262144 + ooff; \
                if (!probe) { *(u32x2*)op = w0; *(u32x2*)(op + 32) = w1; } else asm volatile("" :: "v"(w0.x), "v"(w0.y), "v"(w1.x), "v"(w1.y)); \
                P7B(); \
        } while (0)
        if (steam) {
#pragma unroll 1
            for (int c2 = 0; c2 < 128; c2 += 2) { P7_SSTEP(c2, RB, pfa); P7_SSTEP(c2 + 1, RA, pfb); }
        } else {
#pragma unroll 1
            for (int c2 = 0; c2 < 128; c2 += 2) { P7_OSTEP(c2, RA, pfa); P7_OSTEP(c2 + 1, RB, pfb); }
        }
#undef P7_SSTEP
#undef P7_FARPF
#undef P7_OSTEP
#undef P7_LOADS
#undef P7_STAGE
#undef P7_LOADO
#undef P7_FRAG
        __syncthreads();
    }
}


__device__ __forceinline__ void p8_gn(Frame& F, bool probe) {
    const int gw = blockIdx.x * NWAVES + F.wave, NGW = F.G * NWAVES, lane = F.lane;
    const bf16* O = (const bf16*)(F.ws + WS_VD); bf16* SG = (bf16*)(F.ws + WS_SG); const float* gnw = F.in[14];
    for (int item = gw; item < T * 4; item += NGW) {
        const size_t off = (size_t)item * 512 + 8 * lane; const int hcol = (item & 3) * 512 + 8 * lane;
        const u32x4 ov = *(const u32x4*)(O + off), gv = *(const u32x4*)(SG + off);
        float o[8] = {bf_lo(ov.x), bf_hi(ov.x), bf_lo(ov.y), bf_hi(ov.y), bf_lo(ov.z), bf_hi(ov.z), bf_lo(ov.w), bf_hi(ov.w)};
        float sg[8] = {bf_lo(gv.x), bf_hi(gv.x), bf_lo(gv.y), bf_hi(gv.y), bf_lo(gv.z), bf_hi(gv.z), bf_lo(gv.w), bf_hi(gv.w)};
        float s = 0.f;
#pragma unroll
        for (int j = 0; j < 8; ++j) s += o[j];
        const float mean = wave_sum(s) * (1.0f / 512.0f); float q = 0.f;
#pragma unroll
        for (int j = 0; j < 8; ++j) { o[j] -= mean; q += o[j] * o[j]; }
        const float rs = rsqrtf(wave_sum(q) * (1.0f / 512.0f) + EPS);
        const f32x4 w0 = *(const f32x4*)(gnw + hcol), w1 = *(const f32x4*)(gnw + hcol + 4);
        float y[8];
#pragma unroll
        for (int j = 0; j < 8; ++j) y[j] = sg[j] * o[j] * rs * (j < 4 ? w0[j] : w1[j - 4]);
        u32x4 wv; wv.x = pk2(y[0], y[1]); wv.y = pk2(y[2], y[3]); wv.z = pk2(y[4], y[5]); wv.w = pk2(y[6], y[7]);
        if (!probe) *(u32x4*)(SG + off) = wv; else asm volatile("" :: "v"(wv.x), "v"(wv.y), "v"(wv.z), "v"(wv.w));
    }
}
}
namespace mk {
namespace cg = cooperative_groups;
enum { PH_PREP = 0, PH_S5 = 1, PH_GLU = 2, PH_GU0 = 3, PH_DN0 = 4, PH_PROJ = 5, PH_SCORE = 6, PH_REC = 7, PH_GN = 8, PH_WO = 9, PH_GU1 = 10, PH_DN1 = 11, PH_FINAL = 12, PH_ADAPT = 13 };
struct Args { const float* in[21]; float* out; unsigned char* ws; unsigned mask; unsigned flags; };

__global__ void __launch_bounds__(NTHREADS, 2) mk_fwd(Args a) {
    extern __shared__ __attribute__((aligned(16))) unsigned char lds_raw[];
    cg::grid_group grid = cg::this_grid();
    Frame F;
    F.lds = (LAS unsigned char*)lds_raw; F.tid = threadIdx.x; F.lane = F.tid & 63; F.wave = __builtin_amdgcn_readfirstlane(F.tid >> 6); F.G = gridDim.x;
    TS_INIT(F); F.in = a.in; F.out = a.out; F.ws = a.ws; F.pflags = (a.flags & 1u) ? a.flags : 0u; F.pp = (a.flags & 1u) ? (bf16*)(a.ws + 304 * MiB) : (bf16*)a.out;
    unsigned char* ws = a.ws; const unsigned mask = a.mask; const bool probe = (a.flags & 1u) != 0u;
    float* RX = probe ? (float*)(ws + 304 * MiB) : a.out; bf16* RXB = probe ? (bf16*)(ws + 432 * MiB) : (bf16*)(ws + WS_XB); float* RSSQ = probe ? (float*)(ws + 496 * MiB) : (float*)(ws + WS_SSQ);
    volatile LAS unsigned* MISC = (volatile LAS unsigned*)(F.lds + LDS_BYTES - 256);
    if (F.tid < 64) MISC[F.tid] = 0u;
    __syncthreads();
    XcdBarrier bar = xcd_barrier_post((unsigned*)(ws + WS_CTL) + 1024, MISC + 8);
    TS_START(F);
    bool dirty = false; int nseam = 0;
#ifndef MK_CG_SEAMS
#define MK_CG_SEAMS 0
#endif
#define SEAM() do { if (dirty) { if (nseam < MK_CG_SEAMS) grid.sync(); else xcd_barrier(bar); ++nseam; } dirty = true; } while (0)
#define ON(p) (mask & (1u << (p)))
#ifdef MK_TIMING
#define PTS(p) do { if ((p) / 4 == TGRP) { if ((p) % 4 == 0) TS(F, 0); else if ((p) % 4 == 1) TS(F, 1); else if ((p) % 4 == 2) TS(F, 2); else TS(F, 3); } else TS_START(F); } while (0)
#else
#define PTS(p) do {} while (0)
#endif
    bf16* XB = (bf16*)(ws + WS_XB); float* SSQ = (float*)(ws + WS_SSQ);
    typedef pg8::StaticOrder SO;

    if (ON(PH_PREP) || ON(PH_ADAPT)) {
        SEAM();
        if (ON(PH_PREP)) { if (!(a.flags & 2u)) p0_weights(F); if (!(a.flags & 4u)) p0_s5consts(F); if (!(a.flags & 8u)) rows_to_u(F, a.in[0], a.in[1], (bf16*)(ws + WS_U)); }
    }
    PTS(0);
    if (ON(PH_S5)) { SEAM(); p1_s5(F); } PTS(1);
    if (ON(PH_GLU)) { SEAM();
        pg8::Gemm g{(const bf16*)(ws + WS_YG), (const bf16*)(ws + WS_WGLU), T, D, D}; SO S; S.init(T, D, F.G, (int)blockIdx.x);
        pg8::EpiResid<true> E{a.in[0], RXB, RSSQ, (const bf16*)(ws + WS_YG), a.in[11]};
        pg8::gemm_phase<pg8::EpiResid<true>, SO, true, true>(F.lds, g, S, E); } PTS(2);
#define FFN_PHASES(l, pa, pb) do { \
        if (ON(l ? PH_GU1 : PH_GU0)) { SEAM(); \
            pg8::Gemm g{XB, (const bf16*)(ws + (l ? WS_WGU1 : WS_WGU0)), T, 2 * FF, D}; SO S; S.init(T, 2 * FF, F.G, (int)blockIdx.x); \
            pg8::EpiGateUp E{(bf16*)(ws + WS_H), SSQ, a.flags & 0x70u, F.lds + pg8::STAGE_BYTES}; \
            pg8::gemm_phase<pg8::EpiGateUp, SO, true, true>(F.lds, g, S, E); } PTS(pa); \
        if (ON(l ? PH_DN1 : PH_DN0)) { SEAM(); \
            pg8::Gemm g{(const bf16*)(ws + WS_H), (const bf16*)(ws + (l ? WS_WDN1 : WS_WDN0)), T, D, FF}; SO S; S.init(T, D, F.G, (int)blockIdx.x); \
            pg8::EpiResid<false> E{nullptr, RXB, RSSQ, nullptr, nullptr}; \
            pg8::gemm_phase<pg8::EpiResid<false>, SO, true, true>(F.lds, g, S, E); } PTS(pb); } while (0)
    FFN_PHASES(0, 3, 4);
    if (ON(PH_PROJ)) { SEAM();
        pg8::Gemm g{XB, (const bf16*)(ws + WS_WQKVG), T, PW, D}; SO S; S.init(T, PW, F.G, (int)blockIdx.x);
        pg8::EpiProj E{(bf16*)(ws + WS_Q), (bf16*)(ws + WS_K), (bf16*)(ws + WS_VD), (bf16*)(ws + WS_SG), SSQ, F.lds + pg8::STAGE_BYTES};
        pg8::gemm_phase<pg8::EpiProj, SO, true, true>(F.lds, g, S, E); } PTS(5);
    if (ON(PH_SCORE)) { SEAM(); p6_scores(F); } PTS(6);
    if (ON(PH_REC)) { SEAM(); p7_ret(F, probe); } PTS(7);
    if (ON(PH_GN)) { SEAM(); p8_gn(F, probe); } PTS(8);
    if (ON(PH_WO)) { SEAM();
        pg8::Gemm g{(const bf16*)(ws + WS_SG), (const bf16*)(ws + WS_WO), T, D, 2048}; SO S; S.init(T, D, F.G, (int)blockIdx.x);
        pg8::EpiResid<false> E{nullptr, RXB, RSSQ, nullptr, nullptr};
        pg8::gemm_phase<pg8::EpiResid<false>, SO, true, true>(F.lds, g, S, E); } PTS(9);
    FFN_PHASES(1, 10, 11);
#undef FFN_PHASES
    if (ON(PH_FINAL)) { SEAM(); rows_final(F, XB, a.in[20], RX); } PTS(12);
    TS_SPIN(F);
#undef SEAM
#undef ON
}

static int g_grid = 0;
inline void launch(void* const* d_in, void* d_out, void* d_ws, unsigned mask, hipStream_t stream, unsigned flags = 0) {
    if (g_grid == 0) {
        int dev = 0, cus = 0, per_cu = 0;
        hipGetDevice(&dev); hipDeviceGetAttribute(&cus, hipDeviceAttributeMultiprocessorCount, dev);
        hipFuncSetAttribute((const void*)mk_fwd, hipFuncAttributeMaxDynamicSharedMemorySize, LDS_BYTES);
        hipOccupancyMaxActiveBlocksPerMultiprocessor(&per_cu, (const void*)mk_fwd, NTHREADS, LDS_BYTES);
        if (per_cu < 1) { fprintf(stderr, "mk_fwd: occupancy query says %d blocks per CU\n", per_cu); per_cu = 1; }
        g_grid = cus;
        (void)hipGetLastError();
    }
    (void)hipMemsetAsync(d_ws, 0, 65536, stream);
    Args a{};
    for (int i = 0; i < 21; ++i) a.in[i] = (const float*)d_in[i];
    a.out = (float*)d_out; a.ws = (unsigned char*)d_ws; a.mask = mask; a.flags = flags;
    void* args[] = {&a};
    hipError_t e = hipLaunchCooperativeKernel((const void*)mk_fwd, dim3(g_grid), dim3(NTHREADS), args, LDS_BYTES, stream);
    if (e != hipSuccess) fprintf(stderr, "mk_fwd: cooperative launch failed: %s (grid %d)\n", hipGetErrorString(e), g_grid);
}
}
#ifndef MK_MODE
#define MK_MODE 1
#endif
#define BIT(p) (1u << (mk::p))
extern "C" void kernel_launch(void* const* d_in, const int* in_sizes, int n_in, void* d_out, int out_size, void* d_ws, size_t ws_size, hipStream_t stream) {
    const float* x = (const float*)d_in[0]; float* out = (float*)d_out; char* ws = (char*)d_ws;
#if MK_MODE == 1
    nv::s5_sublayer(d_in, x, out, ws, stream);
    mk::launch(d_in, d_out, d_ws, BIT(PH_ADAPT) | BIT(PH_PREP) | BIT(PH_GU0) | BIT(PH_DN0), stream);
    nv::ret_sublayer(d_in, out, ws, stream);
    mk::launch(d_in, d_out, d_ws, BIT(PH_ADAPT) | BIT(PH_PREP) | BIT(PH_GU1) | BIT(PH_DN1) | BIT(PH_FINAL), stream);
#elif MK_MODE == 2
    mk::launch(d_in, d_out, d_ws, BIT(PH_PREP) | BIT(PH_S5) | BIT(PH_GLU) | BIT(PH_GU0) | BIT(PH_DN0), stream);
    nv::ret_sublayer(d_in, out, ws, stream);
    mk::launch(d_in, d_out, d_ws, BIT(PH_ADAPT) | BIT(PH_PREP) | BIT(PH_GU1) | BIT(PH_DN1) | BIT(PH_FINAL), stream);
#else
    mk::launch(d_in, d_out, d_ws, 0x1fffu, stream);
#ifdef PROBE_MASK
#ifndef PROBE_FLAGS
#define PROBE_FLAGS 0u
#endif
    for (int r = 0; r < PROBE_REP; ++r) mk::launch(d_in, d_out, d_ws, PROBE_MASK, stream, 1u | PROBE_FLAGS);
#endif
#endif
}
```

```cpp
#include <hip/hip_runtime.h>
#include <hip/hip_cooperative_groups.h>
#include <cstdio>
#include <cstdint>
#define MK_MODE 3
#define LAS __attribute__((address_space(3)))
#define GAS __attribute__((address_space(1)))
namespace mk {
typedef unsigned short bf16;
typedef short bf16x8 __attribute__((ext_vector_type(8)));
typedef short s16x4 __attribute__((ext_vector_type(4)));
typedef float f32x4 __attribute__((ext_vector_type(4)));
typedef unsigned u32x4 __attribute__((ext_vector_type(4)));
typedef unsigned u32x2 __attribute__((ext_vector_type(2)));
typedef __bf16 bf2_t __attribute__((ext_vector_type(2)));
typedef float f2_t __attribute__((ext_vector_type(2)));

constexpr int T = 32768, D = 1024, L = 8192, FF = 2816, PW = 6144, NWAVES = 8, NTHREADS = 512;
constexpr float EPS = 1e-6f;
constexpr float LOG2_ROPE = 13.287712379549449f;

constexpr size_t MiB = (size_t)1 << 20;
constexpr size_t WS_CTL = 0;
constexpr size_t WS_SSQ = 1 * MiB;
constexpr size_t WS_WGLU = 8 * MiB;
constexpr size_t WS_WGU0 = 10 * MiB, WS_WGU1 = 21 * MiB;
constexpr size_t WS_WDN0 = 32 * MiB, WS_WDN1 = 38 * MiB;
constexpr size_t WS_WQKVG = 44 * MiB;
constexpr size_t WS_WO = 56 * MiB;
constexpr size_t WS_XB = 64 * MiB;
constexpr size_t WS_U = 128 * MiB, WS_YG = 192 * MiB, WS_S5C = 256 * MiB;
constexpr size_t WS_H = 128 * MiB;
constexpr size_t WS_Q = 128 * MiB, WS_K = 192 * MiB, WS_VD = 256 * MiB, WS_SG = 384 * MiB;
constexpr size_t WS_END = 512 * MiB;
constexpr int S5C_TILES = 0, S5C_WIN = 16384, S5C_WOUT = 16384 + 65536, S5C_A16 = 16384 + 2 * 65536, S5C_STRIDE = S5C_A16 + 512;

constexpr int LDS_BYTES = 147456;

__device__ __forceinline__ unsigned pk2(float lo, float hi) { f2_t v = {lo, hi}; return __builtin_bit_cast(unsigned, __builtin_convertvector(v, bf2_t)); }
__device__ __forceinline__ float bf_lo(unsigned u) { return __uint_as_float(u << 16); }
__device__ __forceinline__ float bf_hi(unsigned u) { return __uint_as_float(u & 0xffff0000u); }
__device__ __forceinline__ float fast_sigmoid(float z) { return __builtin_amdgcn_rcpf(1.0f + __expf(-z)); }
__device__ __forceinline__ float fast_silu(float z) { return z * fast_sigmoid(z); }
__device__ __forceinline__ float log2_gamma(int h) { return log1pf(-exp2f(-5.0f - (float)h)) * 1.4426950408889634f; }
__device__ __forceinline__ void sincos_rev(float x, float& s, float& c) {
    const float hi = x * 0.15915494309189535f;
    const float lo = fmaf(x, 0.15915494309189535f, -hi) + x * 6.4206383e-9f;
    const float fr = (hi - rintf(hi)) + lo;
    s = __builtin_amdgcn_sinf(fr); c = __builtin_amdgcn_cosf(fr);
}
__device__ __forceinline__ float gelu_tanh(float y) {
    const float z = 0.7978845608028654f * (y + 0.044715f * y * y * y);
    const float e = __expf(2.0f * z);
    return 0.5f * y * (2.0f - 2.0f * __builtin_amdgcn_rcpf(e + 1.0f));
}
__device__ __forceinline__ float wave_sum(float v) {
#pragma unroll
    for (int o = 1; o < 64; o <<= 1) v += __shfl_xor(v, o);
    return v;
}
}
namespace mk {
typedef GAS unsigned gu32;
#define RLX_AGENT __ATOMIC_RELAXED, __HIP_MEMORY_SCOPE_AGENT
#define XB_TMO      128
#define XB_XCNT(j)  (256  + 64 * (j))
#define XB_XSUB(j)  (1280 + 64 * (j))
#define XB_XGEN(j)  (2304 + 64 * (j))
#define XB_TOP      3328
#define XB_TOPGEN   3392
#define XCD_BAR_WORDS 3456
#define XB_SPIN_CAP (1u << 18)

__device__ __forceinline__ unsigned xb_ld(unsigned* p)              { return __hip_atomic_load(p, __ATOMIC_RELAXED, __HIP_MEMORY_SCOPE_AGENT); }
__device__ __forceinline__ unsigned xb_add(unsigned* p, unsigned v) { return __hip_atomic_fetch_add(p, v, __ATOMIC_RELAXED, __HIP_MEMORY_SCOPE_AGENT); }
__device__ __forceinline__ unsigned xb_xcc_id() { return (unsigned)__builtin_amdgcn_s_getreg((3 << 11) | 20) & 0xFu; }
#define XB_SPIN(cond, bar) do { unsigned _sp = 0; while (cond) { __builtin_amdgcn_s_sleep(1); \
    if ((++_sp & 255u) == 0u) { if (xb_ld(&(bar)[XB_TMO])) break; if (_sp > XB_SPIN_CAP) { atomicAdd(&(bar)[XB_TMO], 1u); break; } } } } while (0)

struct XcdBarrier {
    unsigned* bar; unsigned x;
    volatile LAS unsigned* st;
};

__device__ __forceinline__ XcdBarrier xcd_barrier_post(unsigned* bar, volatile LAS unsigned* st) {
    XcdBarrier b; b.bar = bar; b.x = xb_xcc_id(); b.st = st;
    if (threadIdx.x == 0) (void)xb_add(&bar[XB_XCNT(b.x)], 1u);
    return b;
}
__device__ __forceinline__ void xcd_barrier_complete(unsigned* bar, unsigned x, unsigned& nloc, unsigned& nx) {
    const unsigned G = gridDim.x * gridDim.y * gridDim.z;
    unsigned sum, cnt, mine, sp = 0u;
    for (;;) {
        sum = 0u; cnt = 0u; mine = 0u;
#pragma unroll
        for (unsigned j = 0; j < 16; ++j) { const unsigned c = xb_ld(&bar[XB_XCNT(j)]); sum += c; cnt += (c > 0u) ? 1u : 0u; mine = (j == x) ? c : mine; }
        if (sum == G) break;
        __builtin_amdgcn_s_sleep(1);
        if ((++sp & 255u) == 0u) { if (xb_ld(&bar[XB_TMO])) break; if (sp > XB_SPIN_CAP) { atomicAdd(&bar[XB_TMO], 1u); break; } }
    }
    nloc = mine > 0u ? mine : 1u; nx = cnt > 0u ? cnt : 1u;
}

__device__ __forceinline__ void xcd_barrier(const XcdBarrier& b) {
    asm volatile("s_waitcnt vmcnt(0)" ::: "memory");
    __syncthreads();
    if (threadIdx.x == 0) {
        unsigned* bar = b.bar;
        __builtin_amdgcn_s_waitcnt(0);
        unsigned nloc = b.st[0], nx = b.st[1];
        if (nloc == 0u) { xcd_barrier_complete(bar, b.x, nloc, nx); b.st[0] = nloc; b.st[1] = nx; }
        const unsigned old = xb_add(&bar[XB_XSUB(b.x)], 1u);
        const unsigned gen = old / nloc;
        if (old + 1u == (gen + 1u) * nloc) {
            __builtin_amdgcn_fence(__ATOMIC_RELEASE, "agent");
            asm volatile("s_waitcnt vmcnt(0)" ::: "memory");
            const unsigned og = xb_add(&bar[XB_TOP], 1u);
            const unsigned tg = og / nx;
            if (og + 1u == (tg + 1u) * nx) xb_add(&bar[XB_TOPGEN], 1u);
            else XB_SPIN(xb_ld(&bar[XB_TOPGEN]) == tg, bar);
            __builtin_amdgcn_fence(__ATOMIC_ACQUIRE, "agent");
            xb_add(&bar[XB_XGEN(b.x)], 1u);
            asm volatile("s_waitcnt vmcnt(0)" ::: "memory");
        } else {
            XB_SPIN(xb_ld(&bar[XB_XGEN(b.x)]) == gen, bar);
            __builtin_amdgcn_fence(__ATOMIC_ACQUIRE, "agent");
            asm volatile("s_waitcnt vmcnt(0)" ::: "memory");
        }
    }
    __syncthreads();
}
}
namespace pg8 {
#define PG8_LAS __attribute__((address_space(3)))
typedef unsigned short bf16_t;
typedef short bf16x8 __attribute__((ext_vector_type(8)));
typedef float f32x4 __attribute__((ext_vector_type(4)));
typedef unsigned u32x4 __attribute__((ext_vector_type(4)));
constexpr int BM = 256, BK = 64, HALF = 128, HTB = HALF * BK * 2  , STAGE_BYTES = 8 * HTB, NXCD = 8, WGM = 8;

__host__ __device__ __forceinline__ int lds_byte(int r, int c) { const int st = (r >> 4) * 2 + (c >> 5), rr = r & 15, cc = c & 31, ob = rr * 64 + cc * 2; return st * 1024 + (ob ^ (((ob >> 9) & 1) << 5)); }
__host__ __device__ __forceinline__ void stage_rc(int b, int& R, int& C) { const int st = b / 1024, sb = b % 1024, swz = sb ^ (((sb >> 9) & 1) << 5); R = (st >> 1) * 16 + swz / 64; C = (st & 1) * 32 + (swz % 64) / 2; }
__host__ __device__ __forceinline__ int perm32(int rho) { const int n = rho >> 4, i = rho & 15; return 8 * (i >> 2) + 4 * n + (i & 3); }

struct Unit { int pm, pn; };
struct Gemm { const bf16_t* A; const bf16_t* Bt; int M, N, K; };

struct StaticOrder {
    int nM, nN, nwg, G, c;
    __host__ __device__ void init(int M, int N, int G_, int c_) { nM = M / BM; nN = N / BM; nwg = nM * nN; G = G_; c = c_; }
    __host__ __device__ bool next(int i, Unit& u) const {
        const long L = (long)i * G + c; if (L >= nwg) return false;
        int wgid = (int)L; { const int q = nwg / NXCD, r = nwg % NXCD, xcd = wgid % NXCD, off = wgid / NXCD; wgid = (xcd < r ? xcd * (q + 1) : r * (q + 1) + (xcd - r) * q) + off; }
        const int nig = WGM * nN, gid = wgid / nig, fm = gid * WGM, gsz = (nM - fm) < WGM ? (nM - fm) : WGM;
        u.pm = fm + ((wgid % nig) % gsz); u.pn = (wgid % nig) / gsz; return true;
    }
    __device__ __forceinline__ void a_ready(const Unit&) const {}
    __device__ __forceinline__ void done(const Unit&) const {}
};

__device__ __forceinline__ unsigned cvt_pk_bf16(float lo, float hi) { unsigned r; asm volatile("v_cvt_pk_bf16_f32 %0, %1, %2" : "=v"(r) : "v"(lo), "v"(hi)); return r; }
typedef float f32x2 __attribute__((ext_vector_type(2)));
template <class Epi, class Sched, bool ALIGN_EPI = false, bool SP2 = false>
__device__ __forceinline__ void gemm_phase(PG8_LAS unsigned char* lds, const Gemm g, const Sched& S, const Epi& E) {
    const int tid = threadIdx.x, wid = __builtin_amdgcn_readfirstlane(tid >> 6), lane = tid & 63, wr = wid >> 2, wc = wid & 3, fr = lane & 15, fq = lane >> 4;
    const int K = g.K, nt = K / BK;
    unsigned voffA[2], voffB[2];
#pragma unroll
    for (int i = 0; i < 2; ++i) { int R, C; stage_rc(tid * 16 + i * 8192, R, C); const int Rb = Epi::PERM ? ((R & ~31) + perm32(R & 31)) : R;
        voffA[i] = (unsigned)(R * K + C) * 2u; voffB[i] = (unsigned)(Rb * K + C) * 2u; }
    const size_t kstep = (size_t)(BK * 2);
    const size_t hstep = (size_t)HALF * K * 2;
    const size_t tstep = 2 * hstep;
    const unsigned ldsw = (unsigned)wid * 1024u;
    const int aoff = lds_byte(wr * 64 + fr, fq * 8), boff = lds_byte(wc * 32 + fr, fq * 8);
#define PG8_SA(b, h) (((b) * 2 + (h)) * HTB)
#define PG8_SB(b, h) ((4 + (b) * 2 + (h)) * HTB)
#define PG8_STAGE(bufoff, gbase, voff) do { _Pragma("unroll") for (int _i = 0; _i < 2; ++_i) \
        __builtin_amdgcn_global_load_lds((const unsigned*)((const char*)(gbase) + (voff)[_i]), (PG8_LAS unsigned*)(lds + (bufoff) + ldsw + _i * 8192), 16, 0, 0); } while (0)
#define PG8_LDA(dst, b, h) do { _Pragma("unroll") for (int m = 0; m < 4; ++m) _Pragma("unroll") for (int k = 0; k < 2; ++k) dst[m][k] = *(const PG8_LAS bf16x8*)(lds + PG8_SA(b, h) + aoff + m * 2048 + k * 1024); } while (0)
#define PG8_LDB(dst, b, h) do { _Pragma("unroll") for (int n = 0; n < 2; ++n) _Pragma("unroll") for (int k = 0; k < 2; ++k) dst[n][k] = *(const PG8_LAS bf16x8*)(lds + PG8_SB(b, h) + boff + n * 2048 + k * 1024); } while (0)
#define PG8_MMA(ai, bj, At, Bt) do { __builtin_amdgcn_s_setprio(1); _Pragma("unroll") for (int m = 0; m < 4; ++m) _Pragma("unroll") for (int n = 0; n < 2; ++n) _Pragma("unroll") for (int k = 0; k < 2; ++k) \
        acc[ai][bj][m][n] = __builtin_amdgcn_mfma_f32_16x16x32_bf16(Bt[n][k], At[m][k], acc[ai][bj][m][n], 0, 0, 0); __builtin_amdgcn_s_setprio(0); } while (0)
#define PG8_WAIT_V(n) asm volatile("s_waitcnt vmcnt(" #n ")" ::: "memory")
#define PG8_WAIT_L(n) asm volatile("s_waitcnt lgkmcnt(" #n ")" ::: "memory")
#define PG8_BAR __builtin_amdgcn_s_barrier()
#define PG8_SCHED __builtin_amdgcn_sched_barrier(0)
    Unit cur, nxt; int ui = 0; typename Epi::Pf pf;
    if (!S.next(0, cur)) return;
    f32x4 acc[2][2][4][2];
#pragma unroll
    for (int a = 0; a < 2; ++a)
#pragma unroll
        for (int b = 0; b < 2; ++b)
#pragma unroll
            for (int m = 0; m < 4; ++m)
#pragma unroll
                for (int n = 0; n < 2; ++n) acc[a][b][m][n] = (f32x4){0.f, 0.f, 0.f, 0.f};
    bf16x8 At[4][2], B0[2][2], B1[2][2];
    const char* cA = (const char*)g.A + (size_t)cur.pm * tstep; const char* cB = (const char*)g.Bt + (size_t)cur.pn * tstep;
    S.a_ready(cur);
    if constexpr (SP2) {
        PG8_STAGE(PG8_SB(0, 0), cB, voffB); PG8_STAGE(PG8_SB(0, 1), cB + hstep, voffB); PG8_STAGE(PG8_SA(0, 0), cA, voffA); PG8_STAGE(PG8_SA(0, 1), cA + hstep, voffA);
        if (wr == 1) PG8_BAR;
        PG8_WAIT_V(2); PG8_BAR;
        PG8_STAGE(PG8_SB(1, 0), cB + kstep, voffB); PG8_STAGE(PG8_SA(1, 0), cA + kstep, voffA); PG8_STAGE(PG8_SB(1, 1), cB + hstep + kstep, voffB);
        PG8_WAIT_V(6); PG8_BAR;
    } else {
        PG8_STAGE(PG8_SB(0, 0), cB, voffB); PG8_STAGE(PG8_SA(0, 0), cA, voffA); PG8_STAGE(PG8_SB(0, 1), cB + hstep, voffB); PG8_STAGE(PG8_SA(0, 1), cA + hstep, voffA);
        if (wr == 1) PG8_BAR;
        PG8_WAIT_V(4); PG8_BAR;
        PG8_STAGE(PG8_SB(1, 0), cB + kstep, voffB); PG8_STAGE(PG8_SA(1, 0), cA + kstep, voffA); PG8_STAGE(PG8_SB(1, 1), cB + hstep + kstep, voffB);
        PG8_WAIT_V(6); PG8_BAR;
    }
    for (;;) {
        const bool has_next = S.next(ui + 1, nxt);
        const char* nA = has_next ? (const char*)g.A + (size_t)nxt.pm * tstep : cA; const char* nB = has_next ? (const char*)g.Bt + (size_t)nxt.pn * tstep : cB;
        for (int t = 0; t < nt; t += 2) {
            const bool last = (t == nt - 2);
            const char* a1 = cA + (size_t)(t + 1) * kstep;
            const char* a2 = last ? nA : cA + (size_t)(t + 2) * kstep; const char* b2 = last ? nB : cB + (size_t)(t + 2) * kstep;
            const char* a3 = a2 + kstep; const char* b3 = b2 + kstep;
            if (last && has_next) S.a_ready(nxt);
            if (t == (nt >= 4 ? nt - 4 : 0)) E.pf_issue(cur, tid, pf);
            if (last) E.pf_commit(pf, tid, lds + STAGE_BYTES);
            if constexpr (SP2) {
            PG8_LDB(B0, 0, 0); PG8_LDB(B1, 0, 1); PG8_SCHED; PG8_LDA(At, 0, 0); PG8_STAGE(PG8_SA(1, 1), a1 + hstep, voffA);
            PG8_WAIT_V(8); PG8_WAIT_L(0); PG8_BAR; PG8_MMA(0, 0, At, B0); PG8_MMA(0, 1, At, B1); PG8_BAR; PG8_SCHED;
            PG8_LDA(At, 0, 1); PG8_STAGE(PG8_SB(0, 0), b2, voffB); PG8_STAGE(PG8_SB(0, 1), b2 + hstep, voffB); PG8_STAGE(PG8_SA(0, 0), a2, voffA);
            PG8_WAIT_V(8); PG8_WAIT_L(0); PG8_BAR; PG8_MMA(1, 0, At, B0); PG8_MMA(1, 1, At, B1); PG8_BAR; PG8_SCHED;
            PG8_LDB(B0, 1, 0); PG8_LDB(B1, 1, 1); PG8_SCHED; PG8_LDA(At, 1, 0); PG8_STAGE(PG8_SA(0, 1), a2 + hstep, voffA);
            PG8_WAIT_V(8); PG8_WAIT_L(0); PG8_BAR; PG8_MMA(0, 0, At, B0); PG8_MMA(0, 1, At, B1); PG8_BAR; PG8_SCHED;
            PG8_LDA(At, 1, 1); PG8_STAGE(PG8_SB(1, 0), b3, voffB); PG8_STAGE(PG8_SB(1, 1), b3 + hstep, voffB); PG8_STAGE(PG8_SA(1, 0), a3, voffA);
            PG8_WAIT_V(8); PG8_WAIT_L(0); PG8_BAR; PG8_MMA(1, 0, At, B0); PG8_MMA(1, 1, At, B1); PG8_BAR; PG8_SCHED;
            } else {
            PG8_LDB(B0, 0, 0); PG8_SCHED; PG8_LDA(At, 0, 0); PG8_STAGE(PG8_SA(1, 1), a1 + hstep, voffA);
            PG8_WAIT_L(8); PG8_BAR; PG8_WAIT_L(0); PG8_MMA(0, 0, At, B0); PG8_BAR; PG8_SCHED;
            PG8_LDB(B1, 0, 1); PG8_STAGE(PG8_SB(0, 0), b2, voffB);
            PG8_BAR; PG8_WAIT_L(0); PG8_MMA(0, 1, At, B1); PG8_BAR;
            PG8_LDA(At, 0, 1); PG8_STAGE(PG8_SA(0, 0), a2, voffA);
            PG8_BAR; PG8_WAIT_L(0); PG8_MMA(1, 0, At, B0); PG8_BAR; PG8_SCHED;
            PG8_STAGE(PG8_SB(0, 1), b2 + hstep, voffB);
            PG8_WAIT_V(6); PG8_BAR; PG8_MMA(1, 1, At, B1); PG8_BAR;
            PG8_LDB(B0, 1, 0); PG8_SCHED; PG8_LDA(At, 1, 0); PG8_STAGE(PG8_SA(0, 1), a2 + hstep, voffA);
            PG8_WAIT_L(8); PG8_BAR; PG8_WAIT_L(0); PG8_MMA(0, 0, At, B0); PG8_BAR; PG8_SCHED;
            PG8_LDB(B1, 1, 1); PG8_STAGE(PG8_SB(1, 0), b3, voffB);
            PG8_BAR; PG8_WAIT_L(0); PG8_MMA(0, 1, At, B1); PG8_BAR;
            PG8_LDA(At, 1, 1); PG8_STAGE(PG8_SA(1, 0), a3, voffA);
            PG8_BAR; PG8_WAIT_L(0); PG8_MMA(1, 0, At, B0); PG8_BAR; PG8_SCHED;
            PG8_STAGE(PG8_SB(1, 1), b3 + hstep, voffB);
            PG8_WAIT_V(6); PG8_BAR; PG8_MMA(1, 1, At, B1); PG8_BAR;
            }
        }
        if constexpr (ALIGN_EPI) { if (wr == 0) PG8_BAR; }
        if constexpr (!Epi::AFTER_DRAIN) { E(acc, cur, wr, wc, fr, fq); S.done(cur); }
        if (!has_next) break;
#pragma unroll
        for (int a = 0; a < 2; ++a)
#pragma unroll
            for (int b = 0; b < 2; ++b)
#pragma unroll
                for (int m = 0; m < 4; ++m)
#pragma unroll
                    for (int n = 0; n < 2; ++n) acc[a][b][m][n] = (f32x4){0.f, 0.f, 0.f, 0.f};
        cur = nxt; cA = nA; cB = nB; ++ui;
        if constexpr (ALIGN_EPI) { if (wr == 1) PG8_BAR; }
    }
    PG8_WAIT_V(0);
    if constexpr (!ALIGN_EPI) { if (wr == 0) PG8_BAR; }
    PG8_BAR;
    if constexpr (Epi::AFTER_DRAIN) { E.fused(acc, cur, wr, wc, fr, fq, lds, wid, lane); S.done(cur); }
#undef PG8_SA
#undef PG8_SB
#undef PG8_STAGE
#undef PG8_LDA
#undef PG8_LDB
#undef PG8_MMA
#undef PG8_WAIT_V
#undef PG8_WAIT_L
#undef PG8_BAR
#undef PG8_SCHED
}
}
namespace pg8 {
using mk::pk2; using mk::bf_lo; using mk::bf_hi;
__device__ __forceinline__ float row_rstd(const float* part, int r, int fq) {
    const f32x4 v = *(const f32x4*)(part + (size_t)r * 16 + 4 * fq);
    float s = (v[0] + v[1]) + (v[2] + v[3]);
    s += __shfl_xor(s, 16); s += __shfl_xor(s, 32);
    return rsqrtf(s * (1.0f / 1024.0f) + mk::EPS);
}
struct PfNone {};
template <bool GLU> struct EpiResid {
    static constexpr bool PERM = true, AFTER_DRAIN = false;
    typedef PfNone Pf;
    __device__ __forceinline__ void pf_issue(const Unit&, int, Pf&) const {}
    __device__ __forceinline__ void pf_commit(const Pf&, int, PG8_LAS unsigned char*) const {}
    const float* xin; bf16_t* xb; float* part; const bf16_t* Yg; const float* bias;
    __device__ __forceinline__ void operator()(const f32x4 (&acc)[2][2][4][2], const Unit& u, int wr, int wc, int fr, int fq) const {
        const int row0 = u.pm * BM + wr * 64 + fr, colb = u.pn * BM + wc * 32 + 8 * fq;
        f32x4 bv[2][2];
        if (GLU) {
#pragma unroll
            for (int bj = 0; bj < 2; ++bj) { bv[bj][0] = *(const f32x4*)(bias + colb + bj * HALF); bv[bj][1] = *(const f32x4*)(bias + colb + bj * HALF + 4); }
        }
        constexpr int MB = GLU ? 2 : 4;
#pragma unroll
        for (int ai = 0; ai < 2; ++ai)
#pragma unroll
            for (int mb = 0; mb < 4; mb += MB) {
                f32x4 x0[MB][2], x1[MB][2]; u32x4 yv[MB][2];
#pragma unroll
                for (int mm = 0; mm < MB; ++mm)
#pragma unroll
                    for (int bj = 0; bj < 2; ++bj) {
                        const size_t off = (size_t)(row0 + ai * HALF + (mb + mm) * 16) * 1024 + colb + bj * HALF;
                        if (GLU) { x0[mm][bj] = *(const f32x4*)(xin + off); x1[mm][bj] = *(const f32x4*)(xin + off + 4); yv[mm][bj] = *(const u32x4*)(Yg + off); }
                        else { yv[mm][bj] = *(const u32x4*)(xb + off); }
                    }
                asm volatile("" ::: "memory");
#pragma unroll
                for (int mm = 0; mm < MB; ++mm) {
                    const int m = mb + mm, r = row0 + ai * HALF + m * 16; float ss = 0.f;
#pragma unroll
                    for (int bj = 0; bj < 2; ++bj) {
                        const size_t off = (size_t)r * 1024 + colb + bj * HALF;
                        f32x4 v0 = acc[ai][bj][m][0], v1 = acc[ai][bj][m][1], xa, xc; const u32x4 y = yv[mm][bj];
                        if (GLU) {
                            const f32x4 b0 = bv[bj][0], b1 = bv[bj][1];
                            v0[0] = bf_lo(y[0]) * mk::fast_sigmoid(v0[0] + b0[0]); v0[1] = bf_hi(y[0]) * mk::fast_sigmoid(v0[1] + b0[1]);
                            v0[2] = bf_lo(y[1]) * mk::fast_sigmoid(v0[2] + b0[2]); v0[3] = bf_hi(y[1]) * mk::fast_sigmoid(v0[3] + b0[3]);
                            v1[0] = bf_lo(y[2]) * mk::fast_sigmoid(v1[0] + b1[0]); v1[1] = bf_hi(y[2]) * mk::fast_sigmoid(v1[1] + b1[1]);
                            v1[2] = bf_lo(y[3]) * mk::fast_sigmoid(v1[2] + b1[2]); v1[3] = bf_hi(y[3]) * mk::fast_sigmoid(v1[3] + b1[3]);
                            xa = x0[mm][bj]; xc = x1[mm][bj];
                        } else {
                            xa = (f32x4){bf_lo(y[0]), bf_hi(y[0]), bf_lo(y[1]), bf_hi(y[1])}; xc = (f32x4){bf_lo(y[2]), bf_hi(y[2]), bf_lo(y[3]), bf_hi(y[3])};
                        }
                        const f32x4 o0 = xa + v0, o1 = xc + v1;
                        u32x4 w; w.x = pk2(o0[0], o0[1]); w.y = pk2(o0[2], o0[3]); w.z = pk2(o1[0], o1[1]); w.w = pk2(o1[2], o1[3]);
                        *(u32x4*)(xb + off) = w;
                        ss += (o0[0] * o0[0] + o0[1] * o0[1]) + (o0[2] * o0[2] + o0[3] * o0[3]) + (o1[0] * o1[0] + o1[1] * o1[1]) + (o1[2] * o1[2] + o1[3] * o1[3]);
                    }
                    ss += __shfl_xor(ss, 16); ss += __shfl_xor(ss, 32);
                    if (fq == 0) part[(size_t)r * 16 + u.pn * 4 + wc] = ss;
                }
            }
    }
};
struct PfRow { f32x4 a, b; };
struct RowScalePf {
    const float* part;
    __device__ __forceinline__ void issue(const Unit& u, int tid, PfRow& pf) const { const float* p = part + (size_t)(u.pm * BM + (tid & 255)) * 16 + 8 * (tid >> 8); pf.a = *(const f32x4*)p; pf.b = *(const f32x4*)(p + 4); }
    __device__ __forceinline__ void commit(const PfRow& pf, int tid, PG8_LAS unsigned char* ldsx) const { ((PG8_LAS float*)ldsx)[tid] = ((pf.a[0] + pf.a[1]) + (pf.a[2] + pf.a[3])) + ((pf.b[0] + pf.b[1]) + (pf.b[2] + pf.b[3])); }
};
__device__ __forceinline__ void tile_rstd(const PG8_LAS unsigned char* ldsx, int wr, int fr, float (&rs)[2][4]) {
    const PG8_LAS float* ps = (const PG8_LAS float*)ldsx;
#pragma unroll
    for (int ai = 0; ai < 2; ++ai)
#pragma unroll
        for (int m = 0; m < 4; ++m) { const int t = ai * HALF + wr * 64 + m * 16 + fr; rs[ai][m] = rsqrtf((ps[t] + ps[256 + t]) * (1.0f / 1024.0f) + mk::EPS); }
}
struct EpiGateUp {
    static constexpr bool PERM = true, AFTER_DRAIN = false;
    typedef PfRow Pf;
    bf16_t* H; const float* part; unsigned skip; const PG8_LAS unsigned char* ldsx;
    __device__ __forceinline__ void pf_issue(const Unit& u, int tid, Pf& pf) const { RowScalePf{part}.issue(u, tid, pf); }
    __device__ __forceinline__ void pf_commit(const Pf& pf, int tid, PG8_LAS unsigned char* lx) const { RowScalePf{part}.commit(pf, tid, lx); }
    __device__ __forceinline__ void operator()(const f32x4 (&acc)[2][2][4][2], const Unit& u, int wr, int wc, int fr, int fq) const {
        if (skip & 16u) { asm volatile("" :: "v"(acc[0][0][0][0][0]), "v"(acc[1][1][3][1][3])); return; }
        const int row0 = u.pm * BM + wr * 64 + fr, col = u.pn * HALF + wc * 32 + 8 * fq;
        float rsv[2][4]; tile_rstd(ldsx, wr, fr, rsv);
        if (skip & 64u) {
#pragma unroll
            for (int ai = 0; ai < 2; ++ai)
#pragma unroll
                for (int m = 0; m < 4; ++m) { const int r = row0 + ai * HALF + m * 16;
                    u32x4 w; w.x = pk2(acc[ai][0][m][0][0], acc[ai][0][m][0][1]); w.y = pk2(acc[ai][0][m][0][2], acc[ai][0][m][0][3]); w.z = pk2(acc[ai][1][m][1][0], acc[ai][1][m][1][1]); w.w = pk2(acc[ai][1][m][1][2], rsv[ai][m]);
                    *(u32x4*)(H + (size_t)r * mk::FF + col) = w; }
            return; }
#pragma unroll
        for (int ai = 0; ai < 2; ++ai)
#pragma unroll
            for (int m = 0; m < 4; ++m) {
                const int r = row0 + ai * HALF + m * 16; const float rs = rsv[ai][m];
                float h[8];
#pragma unroll
                for (int n = 0; n < 2; ++n)
#pragma unroll
                    for (int j = 0; j < 4; ++j) h[4 * n + j] = mk::fast_silu(acc[ai][0][m][n][j] * rs) * (acc[ai][1][m][n][j] * rs);
                u32x4 w; w.x = pk2(h[0], h[1]); w.y = pk2(h[2], h[3]); w.z = pk2(h[4], h[5]); w.w = pk2(h[6], h[7]);
                if (skip & 32u) asm volatile("" :: "v"(w.x), "v"(w.y), "v"(w.z), "v"(w.w)); else
                *(u32x4*)(H + (size_t)r * mk::FF + col) = w;
            }
    }
};
struct EpiProj {
    static constexpr bool PERM = true, AFTER_DRAIN = false;
    typedef PfRow Pf;
    bf16_t *Q, *K, *VD, *SG; const float* part; const PG8_LAS unsigned char* ldsx;
    __device__ __forceinline__ void pf_issue(const Unit& u, int tid, Pf& pf) const { RowScalePf{part}.issue(u, tid, pf); }
    __device__ __forceinline__ void pf_commit(const Pf& pf, int tid, PG8_LAS unsigned char* lx) const { RowScalePf{part}.commit(pf, tid, lx); }
    __device__ __forceinline__ void operator()(const f32x4 (&acc)[2][2][4][2], const Unit& u, int wr, int wc, int fr, int fq) const {
        const int row0 = u.pm * BM + wr * 64 + fr, cin = wc * 32 + 8 * fq;
        float rsv[2][4]; tile_rstd(ldsx, wr, fr, rsv);
        if (u.pn < 8) {
            const int h = u.pn & 3; bf16_t* dst = (u.pn < 4 ? Q : K) + h * 256 + cin; const float sc0 = u.pn < 4 ? 1.0f : 0.0625f;
            float invf[8];
#pragma unroll
            for (int j = 0; j < 8; ++j) invf[j] = exp2f(-((float)(cin + j) * (1.0f / 127.0f)) * mk::LOG2_ROPE);
#pragma unroll
            for (int ai = 0; ai < 2; ++ai)
#pragma unroll
                for (int m = 0; m < 4; ++m) {
                    const int r = row0 + ai * HALF + m * 16; const float sc = rsv[ai][m] * sc0, pos = (float)(r & (mk::L - 1));
                    float o1[8], o2[8];
#pragma unroll
                    for (int n = 0; n < 2; ++n)
#pragma unroll
                        for (int j = 0; j < 4; ++j) { float sn, cs; mk::sincos_rev(pos * invf[4 * n + j], sn, cs);
                            const float t1 = acc[ai][0][m][n][j] * sc, t2 = acc[ai][1][m][n][j] * sc;
                            o1[4 * n + j] = t1 * cs - t2 * sn; o2[4 * n + j] = t1 * sn + t2 * cs; }
                    u32x4 w1, w2; w1.x = pk2(o1[0], o1[1]); w1.y = pk2(o1[2], o1[3]); w1.z = pk2(o1[4], o1[5]); w1.w = pk2(o1[6], o1[7]);
                    w2.x = pk2(o2[0], o2[1]); w2.y = pk2(o2[2], o2[3]); w2.z = pk2(o2[4], o2[5]); w2.w = pk2(o2[6], o2[7]);
                    *(u32x4*)(dst + (size_t)r * 1024) = w1; *(u32x4*)(dst + (size_t)r * 1024 + 128) = w2;
                }
        } else {
            const bool isv = u.pn < 16; const int ct = isv ? u.pn - 8 : u.pn - 16;
            bf16_t* dst = (isv ? VD : SG) + ct * 256 + cin; const float lg = mk::log2_gamma(ct >> 1);
#pragma unroll
            for (int ai = 0; ai < 2; ++ai)
#pragma unroll
                for (int m = 0; m < 4; ++m) {
                    const int r = row0 + ai * HALF + m * 16; const float rs = rsv[ai][m];
                    const float vs = rs * exp2f(lg * (float)(63 - (r & 63)));
#pragma unroll
                    for (int bj = 0; bj < 2; ++bj) {
                        float o[8];
#pragma unroll
                        for (int n = 0; n < 2; ++n)
#pragma unroll
                            for (int j = 0; j < 4; ++j) { const float a = acc[ai][bj][m][n][j]; o[4 * n + j] = isv ? a * vs : mk::fast_silu(a * rs); }
                        u32x4 w; w.x = pk2(o[0], o[1]); w.y = pk2(o[2], o[3]); w.z = pk2(o[4], o[5]); w.w = pk2(o[6], o[7]);
                        *(u32x4*)(dst + (size_t)r * 2048 + bj * HALF) = w;
                    }
                }
        }
    }
};
}
namespace mk {
#define MFMA16(a, b, c) __builtin_amdgcn_mfma_f32_16x16x32_bf16((a), (b), (c), 0, 0, 0)
#define LDS_WAIT() asm volatile("s_waitcnt lgkmcnt(0)" ::: "memory")

struct Frame {
    LAS unsigned char* lds;
    int tid, lane, wave, G;
    const float* const* in; float* out; unsigned char* ws;
    bf16* pp;
};

__device__ __forceinline__ void transpose_item(const float* W, int K, int N, const float* gain, bf16* WT, int mode, int item, LAS float* scr, int lane) {
    const int nblk = N / 32, kb = item / nblk, nb = item % nblk, k0 = 64 * kb, n0 = 32 * nb;
    f32x4 v[8];
#pragma unroll
    for (int i = 0; i < 8; ++i) v[i] = *(const f32x4*)(W + (size_t)(k0 + (lane >> 3) + 8 * i) * N + n0 + 4 * (lane & 7));
#pragma unroll
    for (int i = 0; i < 8; ++i) { const int kk = (lane >> 3) + 8 * i; const float gs = gain ? gain[k0 + kk] : 1.0f; LAS float* d = scr + kk * 33 + 4 * (lane & 7);
        d[0] = v[i][0] * gs; d[1] = v[i][1] * gs; d[2] = v[i][2] * gs; d[3] = v[i][3] * gs; }
    LDS_WAIT(); asm volatile("" ::: "memory");
    const int c = lane & 7;
    const int r0 = (mode == 0) ? n0 : ((n0 >> 7) * 256 + (mode == 2 ? 128 : 0) + (n0 & 127));
#pragma unroll
    for (int j = 0; j < 4; ++j) { const int n = (lane >> 3) + 8 * j; const LAS float* s = scr + (8 * c) * 33 + n;
        u32x4 o; o.x = pk2(s[0 * 33], s[1 * 33]); o.y = pk2(s[2 * 33], s[3 * 33]); o.z = pk2(s[4 * 33], s[5 * 33]); o.w = pk2(s[6 * 33], s[7 * 33]);
        *(u32x4*)(WT + (size_t)(r0 + n) * K + k0 + 8 * c) = o; }
    LDS_WAIT(); asm volatile("" ::: "memory");
}
__device__ __forceinline__ void p0_weights(Frame& F) {
    LAS float* scr = (LAS float*)(F.lds + F.wave * 8448);
    const int gw = blockIdx.x * NWAVES + F.wave, NGW = F.G * NWAVES;
    constexpr int I_GLU = 16 * 32, I_GU = 16 * 88, I_DN = 44 * 32, I_QK = 16 * 192, I_WO = 32 * 32;
    constexpr int NITEMS = I_GLU + 2 * (2 * I_GU + I_DN) + I_QK + I_WO;
    unsigned char* ws = F.ws;
    for (int it = gw; it < NITEMS; it += NGW) {
        int r = it;
        if (r < I_GLU) { transpose_item(F.in[10], D, D, nullptr, (bf16*)(ws + WS_WGLU), 0, r, scr, F.lane); continue; } r -= I_GLU;
        bool done = false;
#pragma unroll
        for (int l = 0; l < 2; ++l) {
            if (done) break;
            bf16* gu = (bf16*)(ws + (l ? WS_WGU1 : WS_WGU0)); bf16* dn = (bf16*)(ws + (l ? WS_WDN1 : WS_WDN0));
            if (r < I_GU) { transpose_item(F.in[17] + (size_t)l * D * FF, D, FF, F.in[16] + l * D, gu, 1, r, scr, F.lane); done = true; break; } r -= I_GU;
            if (r < I_GU) { transpose_item(F.in[18] + (size_t)l * D * FF, D, FF, F.in[16] + l * D, gu, 2, r, scr, F.lane); done = true; break; } r -= I_GU;
            if (r < I_DN) { transpose_item(F.in[19] + (size_t)l * FF * D, FF, D, nullptr, dn, 0, r, scr, F.lane); done = true; break; } r -= I_DN;
        }
        if (done) continue;
        if (r < I_QK) { transpose_item(F.in[13], D, PW, F.in[12], (bf16*)(ws + WS_WQKVG), 0, r, scr, F.lane); continue; } r -= I_QK;
        transpose_item(F.in[15], 2048, D, nullptr, (bf16*)(ws + WS_WO), 0, r, scr, F.lane);
    }
}

__device__ __forceinline__ void p0_s5consts(Frame& F) {
    LAS float* ap = (LAS float*)(F.lds + 70000 - 70000 % 16);
    LAS float* bb = ap + 17 * 64 * 2;
    LAS float* cc = bb + 64 * 16 * 2;
    for (int item = blockIdx.x; item < 256; item += F.G) {
        const int g = item >> 2, part = item & 3, tid = F.tid;
        __syncthreads();
        if (tid < 64) {
            const int p = tid; const float lr = F.in[2][g * 64 + p], li = F.in[3][g * 64 + p], dt = expf(F.in[4][g]);
#pragma unroll 1
            for (int l = 0; l <= 16; ++l) { const float er = expf(lr * dt * (float)l); float sn, cs; sincos_rev(li * dt * (float)l, sn, cs); ap[(l * 64 + p) * 2] = er * cs; ap[(l * 64 + p) * 2 + 1] = er * sn; }
            const float er = expf(lr * dt); float sn, cs; sincos_rev(li * dt, sn, cs);
            const float ar = er * cs, ai = er * sn, nr = ar - 1.0f, ni = ai, den = lr * lr + li * li;
            const float fr = (nr * lr + ni * li) / den, fi = (ni * lr - nr * li) / den;
#pragma unroll 1
            for (int m = 0; m < 16; ++m) { const float br = F.in[5][(g * 64 + p) * 16 + m], bi = F.in[6][(g * 64 + p) * 16 + m]; bb[(p * 16 + m) * 2] = fr * br - fi * bi; bb[(p * 16 + m) * 2 + 1] = fr * bi + fi * br; }
        }
        for (int e = tid; e < 1024; e += NTHREADS) { cc[e * 2] = F.in[7][g * 1024 + e]; cc[e * 2 + 1] = F.in[8][g * 1024 + e]; }
        __syncthreads();
        unsigned char* sc = F.ws + WS_S5C + (size_t)g * S5C_STRIDE;
        bf16* tiles = (bf16*)(sc + S5C_TILES); bf16* win = (bf16*)(sc + S5C_WIN); bf16* wout = (bf16*)(sc + S5C_WOUT); float* a16 = (float*)(sc + S5C_A16);
        for (int e = tid; e < 1024; e += NTHREADS) {
            const int l = 4 * part + (e >> 8), n = (e >> 4) & 15, m = e & 15; float s = 0.f;
            for (int p = 0; p < 64; ++p) { const float ar = ap[(l * 64 + p) * 2], ai = ap[(l * 64 + p) * 2 + 1], br = bb[(p * 16 + m) * 2], bi = bb[(p * 16 + m) * 2 + 1];
                const float tr = ar * br - ai * bi, ti = ar * bi + ai * br; s += cc[(n * 64 + p) * 2] * tr - cc[(n * 64 + p) * 2 + 1] * ti; }
            if (l == 0 && n == m) s += F.in[9][g * 16 + n];
            const bf16 v = (bf16)(pk2(s, 0.f) & 0xffffu);
            tiles[(l * 16 + n) * 32 + m] = v;
            if (l + 1 <= 15) tiles[((l + 1) * 16 + n) * 32 + 16 + m] = v;
            if (l == 0) tiles[(0 * 16 + n) * 32 + 16 + m] = 0;
        }
        for (int e = tid; e < 8192; e += NTHREADS) {
            const int q = e >> 6, j = 4 * part + ((e >> 4) & 3), m = e & 15, p = q & 63, l = 15 - j;
            const float ar = ap[(l * 64 + p) * 2], ai = ap[(l * 64 + p) * 2 + 1], br = bb[(p * 16 + m) * 2], bi = bb[(p * 16 + m) * 2 + 1];
            const float v = q < 64 ? ar * br - ai * bi : ar * bi + ai * br;
            win[q * 256 + j * 16 + m] = (bf16)(pk2(v, 0.f) & 0xffffu);
        }
        for (int e = tid; e < 8192; e += NTHREADS) {
            const int i = 4 * part + (e >> 11), n = (e >> 7) & 15, q = e & 127, p = q & 63, l = i + 1;
            const float ar = ap[(l * 64 + p) * 2], ai = ap[(l * 64 + p) * 2 + 1], cr = cc[(n * 64 + p) * 2], ci = cc[(n * 64 + p) * 2 + 1];
            const float v = q < 64 ? cr * ar - ci * ai : -(cr * ai + ci * ar);
            wout[(i * 16 + n) * 128 + q] = (bf16)(pk2(v, 0.f) & 0xffffu);
        }
        if (part == 0 && tid < 64) { a16[tid * 2] = ap[(16 * 64 + tid) * 2]; a16[tid * 2 + 1] = ap[(16 * 64 + tid) * 2 + 1]; }
    }
}

__device__ __forceinline__ void rows_to_u(Frame& F, const float* x, const float* g, bf16* dst) {
    const int gw = blockIdx.x * NWAVES + F.wave, NGW = F.G * NWAVES, lane = F.lane;
    for (int m = gw; m < T; m += NGW) {
        const f32x4* xr = (const f32x4*)(x + (size_t)m * D) + lane;
        f32x4 v[4]; float s = 0.f;
#pragma unroll
        for (int j = 0; j < 4; ++j) { v[j] = xr[64 * j]; s += (v[j][0] * v[j][0] + v[j][1] * v[j][1]) + (v[j][2] * v[j][2] + v[j][3] * v[j][3]); }
        s = wave_sum(s);
        const float rs = rsqrtf(s * (1.0f / D) + EPS);
        u32x2* o = (u32x2*)(dst + (size_t)m * D) + lane;
#pragma unroll
        for (int j = 0; j < 4; ++j) { const f32x4 gv = *((const f32x4*)g + lane + 64 * j); const f32x4 y = v[j] * rs * gv; u32x2 w; w.x = pk2(y[0], y[1]); w.y = pk2(y[2], y[3]); o[64 * j] = w; }
    }
}
__device__ __forceinline__ void rows_final(Frame& F, const bf16* xb, const float* g, float* dst) {
    const int gw = blockIdx.x * NWAVES + F.wave, NGW = F.G * NWAVES, lane = F.lane;
    for (int m = gw; m < T; m += NGW) {
        const u32x4* xr = (const u32x4*)(xb + (size_t)m * D) + lane;
        float v[2][8]; float s = 0.f;
#pragma unroll
        for (int j = 0; j < 2; ++j) { const u32x4 u = xr[64 * j];
            v[j][0] = bf_lo(u.x); v[j][1] = bf_hi(u.x); v[j][2] = bf_lo(u.y); v[j][3] = bf_hi(u.y); v[j][4] = bf_lo(u.z); v[j][5] = bf_hi(u.z); v[j][6] = bf_lo(u.w); v[j][7] = bf_hi(u.w);
#pragma unroll
            for (int e = 0; e < 8; ++e) s += v[j][e] * v[j][e]; }
        s = wave_sum(s);
        const float rs = rsqrtf(s * (1.0f / D) + EPS);
#pragma unroll
        for (int j = 0; j < 2; ++j) { const f32x4 g0 = *(const f32x4*)(g + 8 * lane + 512 * j), g1 = *(const f32x4*)(g + 8 * lane + 512 * j + 4);
            f32x4 o0, o1;
#pragma unroll
            for (int e = 0; e < 4; ++e) { o0[e] = v[j][e] * rs * g0[e]; o1[e] = v[j][4 + e] * rs * g1[e]; }
            float* op = dst + (size_t)m * D + 8 * lane + 512 * j; *(f32x4*)op = o0; *(f32x4*)(op + 4) = o1; }
    }
}

__device__ __forceinline__ void p1_s5(Frame& F) {
    constexpr int UBB = 16896, ZB_OFF = 2 * UBB, XS_OFF = ZB_OFF + 16896, YB_OFF = XS_OFF + 8704;
    const int tid = F.tid, w = F.wave, lane = F.lane, lr = lane & 15, lg = lane >> 4;
    for (int unit = blockIdx.x; unit < 256; unit += F.G) {
        const int xcd = unit & 7, slot = unit >> 3, g = 8 * xcd + (slot & 7), b = slot >> 3;
        const unsigned char* sc = F.ws + WS_S5C + (size_t)g * S5C_STRIDE;
        const bf16* tiles = (const bf16*)(sc + S5C_TILES); const bf16* win = (const bf16*)(sc + S5C_WIN); const bf16* wout = (const bf16*)(sc + S5C_WOUT); const float* a16 = (const float*)(sc + S5C_A16);
        const bf16* Ub = (const bf16*)(F.ws + WS_U) + (size_t)b * L * D + g * 16;
        bf16* Yb = (bf16*)(F.ws + WS_YG) + (size_t)b * L * D + g * 16;
        const int ilo = w, ihi = 15 - w;
        bf16x8 WinF[8], WoF[2][4], Tlo[4], Thi[8];
#pragma unroll
        for (int ks = 0; ks < 8; ++ks) WinF[ks] = *(const bf16x8*)(win + (16 * w + lr) * 256 + 32 * ks + 8 * lg);
#pragma unroll
        for (int ks = 0; ks < 4; ++ks) { WoF[0][ks] = *(const bf16x8*)(wout + (ilo * 16 + lr) * 128 + 32 * ks + 8 * lg); WoF[1][ks] = *(const bf16x8*)(wout + (ihi * 16 + lr) * 128 + 32 * ks + 8 * lg); }
#pragma unroll
        for (int jp = 0; jp < 4; ++jp) { const int e = ilo - 2 * jp; Tlo[jp] = *(const bf16x8*)(tiles + ((e < 0 ? 0 : e) * 16 + lr) * 32 + 8 * lg); }
#pragma unroll
        for (int jp = 0; jp < 8; ++jp) { const int e = ihi - 2 * jp; Thi[jp] = *(const bf16x8*)(tiles + ((e < 0 ? 0 : e) * 16 + lr) * 32 + 8 * lg); }
        const float a16r = a16[(lane) * 2], a16i = a16[(lane) * 2 + 1];
        float xr = 0.f, xi = 0.f;
        u32x4 ur0, ur1;
        { const bf16* up = Ub + (size_t)tid * D; ur0 = *(const u32x4*)up; ur1 = *(const u32x4*)(up + 8); }
        { LAS unsigned char* ub = F.lds + (tid >> 4) * 528 + (tid & 15) * 32; *(LAS u32x4*)ub = ur0; *(LAS u32x4*)(ub + 16) = ur1; }
        __syncthreads();
#define P1_FLUSH(sp) do { _Pragma("unroll") for (int j_ = 0; j_ < 2; ++j_) { const int tk_ = (tid >> 1) + 256 * j_; \
            const LAS unsigned char* yp_ = F.lds + YB_OFF + (tk_ >> 4) * 520 + (tk_ & 15) * 32 + (tid & 1) * 16; \
            const u32x2 lo_ = *(const LAS u32x2*)yp_, hi_ = *(const LAS u32x2*)(yp_ + 8); \
            *(u32x4*)(Yb + (size_t)((sp) * 512 + tk_) * D + (tid & 1) * 8) = (u32x4){lo_.x, lo_.y, hi_.x, hi_.y}; } } while (0)
#pragma unroll 1
        for (int s = 0; s < 16; ++s) {
            LAS unsigned char* UBc = F.lds + (s & 1) * UBB; LAS unsigned char* UBn = F.lds + ((s + 1) & 1) * UBB;
            if (s + 1 < 16) { const bf16* up = Ub + (size_t)((s + 1) * 512 + tid) * D; ur0 = *(const u32x4*)up; ur1 = *(const u32x4*)(up + 8); }
            {
                f32x4 z0 = {0.f, 0.f, 0.f, 0.f}, z1 = z0;
#pragma unroll
                for (int ks = 0; ks < 8; ++ks) {
                    const LAS unsigned char* a = UBc + lr * 528 + (2 * ks + (lg >> 1)) * 32 + (lg & 1) * 16;
                    const bf16x8 u0 = *(const LAS bf16x8*)a, u1 = *(const LAS bf16x8*)(a + 16 * 528);
                    z0 = MFMA16(WinF[ks], u0, z0); z1 = MFMA16(WinF[ks], u1, z1);
                }
                LAS unsigned char* zb = F.lds + ZB_OFF + lr * 528 + (16 * w + 4 * lg) * 4;
                *(LAS f32x4*)zb = z0; *(LAS f32x4*)(zb + 16 * 528) = z1;
            }
            __syncthreads();
            if (w == 0) {
                const LAS float* zf = (const LAS float*)(F.lds + ZB_OFF); LAS bf16* xs = (LAS bf16*)(F.lds + XS_OFF);
#pragma unroll
                for (int hc = 0; hc < 2; ++hc) {
                    float zr[16], zi[16];
#pragma unroll
                    for (int c = 0; c < 16; ++c) { zr[c] = zf[(16 * hc + c) * 132 + lane]; zi[c] = zf[(16 * hc + c) * 132 + 64 + lane]; }
#pragma unroll
                    for (int c = 0; c < 16; ++c) {
                        const unsigned pk = pk2(xr, xi);
                        xs[(16 * hc + c) * 136 + lane] = (bf16)(pk & 0xffffu); xs[(16 * hc + c) * 136 + 64 + lane] = (bf16)(pk >> 16);
                        const float nr = a16r * xr - a16i * xi + zr[c], ni = a16r * xi + a16i * xr + zi[c]; xr = nr; xi = ni;
                    }
                }
            }
            if (s + 1 < 16) { LAS unsigned char* ub = UBn + (tid >> 4) * 528 + (tid & 15) * 32; *(LAS u32x4*)ub = ur0; *(LAS u32x4*)(ub + 16) = ur1; }
            if (s > 0) P1_FLUSH(s - 1);
            __syncthreads();
#pragma unroll
            for (int ii = 0; ii < 2; ++ii) {
                const int i = ii ? ihi : ilo;
                f32x4 a0 = {0.f, 0.f, 0.f, 0.f}, a1 = a0;
#pragma unroll
                for (int jp = 0; jp < (ii ? 8 : 4); ++jp) {
                    if (jp <= (i >> 1)) {
                        const LAS unsigned char* a = UBc + lr * 528 + (2 * jp + (lg >> 1)) * 32 + (lg & 1) * 16;
                        const bf16x8 u0 = *(const LAS bf16x8*)a, u1 = *(const LAS bf16x8*)(a + 16 * 528);
                        const bf16x8 tt = ii ? Thi[jp] : Tlo[jp];
                        a0 = MFMA16(tt, u0, a0); a1 = MFMA16(tt, u1, a1);
                    }
                }
#pragma unroll
                for (int ks = 0; ks < 4; ++ks) {
                    const LAS unsigned char* a = F.lds + XS_OFF + lr * 272 + (32 * ks + 8 * lg) * 2;
                    const bf16x8 x0 = *(const LAS bf16x8*)a, x1 = *(const LAS bf16x8*)(a + 16 * 272);
                    a0 = MFMA16(WoF[ii][ks], x0, a0); a1 = MFMA16(WoF[ii][ks], x1, a1);
                }
                { u32x2 o; o.x = pk2(gelu_tanh(a0[0]), gelu_tanh(a0[1])); o.y = pk2(gelu_tanh(a0[2]), gelu_tanh(a0[3]));
                  *(LAS u32x2*)(F.lds + YB_OFF + lr * 520 + i * 32 + lg * 8) = o; }
                { u32x2 o; o.x = pk2(gelu_tanh(a1[0]), gelu_tanh(a1[1])); o.y = pk2(gelu_tanh(a1[2]), gelu_tanh(a1[3]));
                  *(LAS u32x2*)(F.lds + YB_OFF + (16 + lr) * 520 + i * 32 + lg * 8) = o; }
            }
        }
        __syncthreads();
        P1_FLUSH(15);
#undef P1_FLUSH
        __syncthreads();
    }
}

__device__ __forceinline__ void p6_scores(Frame& F) {
    const int w = F.wave, lane = F.lane, lr = lane & 15, lg = lane >> 4, it = w & 3, jh = w >> 2;
    const bf16* Q = (const bf16*)(F.ws + WS_Q); const bf16* K = (const bf16*)(F.ws + WS_K); bf16* PP = F.pp;
    for (int unit = blockIdx.x; unit < 2048; unit += F.G) {
        const int c = unit & 127, bh = unit >> 7, b = bh >> 2, h = bh & 3; const float lg2 = log2_gamma(h);
        const size_t tokbase = (size_t)b * L + c * 64;
        bf16x8 qf[8];
#pragma unroll
        for (int ks = 0; ks < 8; ++ks) qf[ks] = *(const bf16x8*)(Q + (tokbase + 16 * it + lr) * 1024 + 256 * h + 32 * ks + 8 * lg);
#pragma unroll
        for (int jt = 0; jt < 2; ++jt) {
            f32x4 acc = {0.f, 0.f, 0.f, 0.f};
#pragma unroll
            for (int ks = 0; ks < 8; ++ks) { const bf16x8 kf = *(const bf16x8*)(K + (tokbase + 32 * jh + 16 * jt + lr) * 1024 + 256 * h + 32 * ks + 8 * lg); acc = MFMA16(kf, qf[ks], acc); }
            const int i = 16 * it + lr, j0 = 32 * jh + 16 * jt + 4 * lg; float o[4];
#pragma unroll
            for (int r = 0; r < 4; ++r) { const int j = j0 + r; const int ex = (j <= i) ? -64 : 2 * (j - i) - 64; o[r] = acc[r] * exp2f(lg2 * (float)ex); }
            u32x2 wv; wv.x = pk2(o[0], o[1]); wv.y = pk2(o[2], o[3]);
            *(u32x2*)(PP + (size_t)unit * 4096 + i * 64 + j0) = wv;
        }
    }
}

#define TR8(d0, d1, d2, d3, d4, d5, d6, d7, addr, o0, o1, o2, o3, o4, o5, o6, o7) \
    asm volatile("ds_read_b64_tr_b16 %0, %8 offset:%9\n\tds_read_b64_tr_b16 %1, %8 offset:%10\n\tds_read_b64_tr_b16 %2, %8 offset:%11\n\tds_read_b64_tr_b16 %3, %8 offset:%12\n\t" \
                 "ds_read_b64_tr_b16 %4, %8 offset:%13\n\tds_read_b64_tr_b16 %5, %8 offset:%14\n\tds_read_b64_tr_b16 %6, %8 offset:%15\n\tds_read_b64_tr_b16 %7, %8 offset:%16\n\ts_waitcnt lgkmcnt(0)" \
                 : "=&v"(d0), "=&v"(d1), "=&v"(d2), "=&v"(d3), "=&v"(d4), "=&v"(d5), "=&v"(d6), "=&v"(d7) \
                 : "v"(addr), "i"(o0), "i"(o1), "i"(o2), "i"(o3), "i"(o4), "i"(o5), "i"(o6), "i"(o7) : "memory")
__device__ __forceinline__ bf16x8 cat8(s16x4 lo, s16x4 hi) { return (bf16x8){lo[0], lo[1], lo[2], lo[3], hi[0], hi[1], hi[2], hi[3]}; }

struct P7Regs { u32x4 kr[4]; u32x4 vr; bf16x8 qf[4]; bf16x8 pf; };
struct P7Ctx { const bf16 *Kp, *Qp, *Pp; bf16* Vp; int tid; };
__device__ __forceinline__ void p7_load_kv(const P7Ctx& C, P7Regs& R, int c) {
#pragma unroll
    for (int i = 0; i < 4; ++i) { const int id = C.tid + 512 * i; R.kr[i] = *(const u32x4*)(C.Kp + (size_t)(c * 64 + (id >> 5)) * 1024 + 8 * (id & 31)); }
    if (C.tid < 256) R.vr = *(const u32x4*)(C.Vp + (size_t)(c * 64 + (C.tid >> 2)) * 2048 + 8 * (C.tid & 3));
}
__device__ __forceinline__ void p7_load_qp(const P7Ctx& C, P7Regs& R, int c) {
#pragma unroll
    for (int ks = 0; ks < 4; ++ks) R.qf[ks] = *(const bf16x8*)(C.Qp + (size_t)c * 64 * 1024 + 32 * ks);
    R.pf = *(const bf16x8*)(C.Pp + (size_t)c * 4096);
}

__device__ __forceinline__ void p7_ret(Frame& F, bool probe) {
    constexpr int SBB = 16896, KBB = 33792, VBB = 5120, OBB = 8192, SB_OFF = 0, KB_OFF = 2 * SBB, VB_OFF = KB_OFF + 2 * KBB, OB_OFF = VB_OFF + 2 * VBB;
    const int tid = F.tid, w = F.wave, lane = F.lane, lr = lane & 15, lg = lane >> 4, it = w & 3, dh = w >> 2, dq = w & 3, q_ = lr >> 2, p_ = lr & 3;
    for (int unit = blockIdx.x; unit < 256; unit += F.G) {
        const int xcd = unit & 7, slot = unit >> 3, bh = 2 * xcd + (slot >> 4), es = slot & 15, b = bh >> 2, h = bh & 3;
        const float lg2 = log2_gamma(h), cd = exp2f(64.0f * lg2), rowscale = exp2f((float)(16 * it + lr + 1) * lg2);
        P7Ctx C;
        C.tid = tid;
        C.Qp = (const bf16*)(F.ws + WS_Q) + (size_t)b * L * 1024 + 256 * h + (size_t)(16 * it + lr) * 1024 + 128 * dh + 8 * lg;
        C.Kp = (const bf16*)(F.ws + WS_K) + (size_t)b * L * 1024 + 256 * h;
        C.Vp = (bf16*)(F.ws + WS_VD) + (size_t)b * L * 2048 + h * 512 + es * 32;
        C.Pp = (const bf16*)F.pp + (size_t)bh * 128 * 4096 + (16 * it + lr) * 64 + 32 * dh + 8 * lg;
        f32x4 S[4];
#pragma unroll
        for (int mt = 0; mt < 4; ++mt) S[mt] = (f32x4){0.f, 0.f, 0.f, 0.f};
        f32x4 ap0 = {0.f, 0.f, 0.f, 0.f}, ap1 = ap0;
        P7Regs RA, RB; RA.vr = (u32x4){0u, 0u, 0u, 0u}; RB.vr = RA.vr;
        p7_load_kv(C, RA, 0); p7_load_qp(C, RA, 0); p7_load_kv(C, RB, 1); p7_load_qp(C, RB, 1);
#define P7_STEP(c, R) do { \
            LAS unsigned char* SBc = F.lds + SB_OFF + ((c) & 1) * SBB; LAS unsigned char* KBc = F.lds + KB_OFF + ((c) & 1) * KBB; \
            LAS unsigned char* VBc = F.lds + VB_OFF + ((c) & 1) * VBB; LAS unsigned char* OBc = F.lds + OB_OFF + ((c) & 1) * OBB; LAS unsigned char* OBp = F.lds + OB_OFF + (((c) + 1) & 1) * OBB; \
            _Pragma("unroll") for (int mt = 0; mt < 4; ++mt) { u32x2 wv; wv.x = pk2(S[mt][0], S[mt][1]); wv.y = pk2(S[mt][2], S[mt][3]); *(LAS u32x2*)(SBc + (16 * dh + lr) * 528 + (64 * dq + 16 * mt + 4 * lg) * 2) = wv; } \
            _Pragma("unroll") for (int i = 0; i < 4; ++i) { const int id = tid + 512 * i; *(LAS u32x4*)(KBc + (id >> 5) * 528 + (id & 31) * 16) = R.kr[i]; } \
            if (tid < 256) *(LAS u32x4*)(VBc + (tid >> 2) * 80 + (tid & 3) * 16) = R.vr; \
            if ((c) + 2 < 128) p7_load_kv(C, R, (c) + 2); \
            __syncthreads(); \
              \
            if (dh == 0 && (c) > 0) { \
                const f32x4 b0 = *(const LAS f32x4*)(OBp + ((it * 2 + 0) * 64 + lane) * 16), b1 = *(const LAS f32x4*)(OBp + ((it * 2 + 1) * 64 + lane) * 16); \
                const f32x4 o0 = (ap0 + b0) * rowscale, o1 = (ap1 + b1) * rowscale; \
                u32x2 w0, w1; w0.x = pk2(o0[0], o0[1]); w0.y = pk2(o0[2], o0[3]); w1.x = pk2(o1[0], o1[1]); w1.y = pk2(o1[2], o1[3]); \
                bf16* op = C.Vp + (size_t)(((c) - 1) * 64 + 16 * it + lr) * 2048 + 4 * lg; \
                if (!probe) { *(u32x2*)op = w0; *(u32x2*)(op + 16) = w1; } else asm volatile("" :: "v"(w0.x), "v"(w0.y), "v"(w1.x), "v"(w1.y)); \
            } \
              \
            s16x4 v0, v1, v2, v3, v4, v5, v6, v7; \
            { const unsigned va = (unsigned)(uintptr_t)(VBc + (8 * lg + q_) * 80 + (4 * p_) * 2); \
              TR8(v0, v1, v2, v3, v4, v5, v6, v7, va, 0, 4 * 80, 32, 4 * 80 + 32, 32 * 80, 36 * 80, 32 * 80 + 32, 36 * 80 + 32); } \
            const bf16x8 vt00 = cat8(v0, v1), vt10 = cat8(v2, v3), vt01 = cat8(v4, v5), vt11 = cat8(v6, v7);     \
              \
            f32x4 a0 = {0.f, 0.f, 0.f, 0.f}, a1 = a0; \
            _Pragma("unroll") for (int ks = 0; ks < 4; ++ks) { \
                const bf16x8 s0 = *(const LAS bf16x8*)(SBc + lr * 528 + (128 * dh + 32 * ks + 8 * lg) * 2), s1 = *(const LAS bf16x8*)(SBc + (16 + lr) * 528 + (128 * dh + 32 * ks + 8 * lg) * 2); \
                a0 = MFMA16(s0, R.qf[ks], a0); a1 = MFMA16(s1, R.qf[ks], a1); } \
            a0 = MFMA16(dh ? vt01 : vt00, R.pf, a0); a1 = MFMA16(dh ? vt11 : vt10, R.pf, a1); \
            if ((c) + 2 < 128) p7_load_qp(C, R, (c) + 2); \
            if (dh == 1) { *(LAS f32x4*)(OBc + ((it * 2 + 0) * 64 + lane) * 16) = a0; *(LAS f32x4*)(OBc + ((it * 2 + 1) * 64 + lane) * 16) = a1; } else { ap0 = a0; ap1 = a1; } \
              \
            const unsigned ka = (unsigned)(uintptr_t)(KBc + (8 * lg + q_) * 528 + (64 * dq + 4 * p_) * 2); \
            { s16x4 k0, k1, k2, k3, k4, k5, k6, k7; \
              TR8(k0, k1, k2, k3, k4, k5, k6, k7, ka, 0, 4 * 528, 32, 4 * 528 + 32, 64, 4 * 528 + 64, 96, 4 * 528 + 96); \
              const bf16x8 vt = dh ? vt10 : vt00; \
              _Pragma("unroll") for (int mt = 0; mt < 4; ++mt) S[mt] = S[mt] * cd; \
              S[0] = MFMA16(cat8(k0, k1), vt, S[0]); S[1] = MFMA16(cat8(k2, k3), vt, S[1]); S[2] = MFMA16(cat8(k4, k5), vt, S[2]); S[3] = MFMA16(cat8(k6, k7), vt, S[3]); } \
            { s16x4 k0, k1, k2, k3, k4, k5, k6, k7; \
              TR8(k0, k1, k2, k3, k4, k5, k6, k7, ka, 32 * 528, 36 * 528, 32 * 528 + 32, 36 * 528 + 32, 32 * 528 + 64, 36 * 528 + 64, 32 * 528 + 96, 36 * 528 + 96); \
              const bf16x8 vt = dh ? vt11 : vt01; \
              S[0] = MFMA16(cat8(k0, k1), vt, S[0]); S[1] = MFMA16(cat8(k2, k3), vt, S[1]); S[2] = MFMA16(cat8(k4, k5), vt, S[2]); S[3] = MFMA16(cat8(k6, k7), vt, S[3]); } \
        } while (0)
#pragma unroll 1
        for (int c2 = 0; c2 < 128; c2 += 2) { P7_STEP(c2, RA); P7_STEP(c2 + 1, RB); }
#undef P7_STEP
        __syncthreads();
        if (dh == 0) {
            LAS unsigned char* OBp = F.lds + OB_OFF + (127 & 1) * OBB;
            const f32x4 b0 = *(const LAS f32x4*)(OBp + ((it * 2 + 0) * 64 + lane) * 16), b1 = *(const LAS f32x4*)(OBp + ((it * 2 + 1) * 64 + lane) * 16);
            const f32x4 o0 = (ap0 + b0) * rowscale, o1 = (ap1 + b1) * rowscale;
            u32x2 w0, w1; w0.x = pk2(o0[0], o0[1]); w0.y = pk2(o0[2], o0[3]); w1.x = pk2(o1[0], o1[1]); w1.y = pk2(o1[2], o1[3]);
            bf16* op = C.Vp + (size_t)(127 * 64 + 16 * it + lr) * 2048 + 4 * lg;
            if (!probe) { *(u32x2*)op = w0; *(u32x2*)(op + 16) = w1; } else asm volatile("" :: "v"(w0.x), "v"(w0.y), "v"(w1.x), "v"(w1.y));
        }
        __syncthreads();
    }
}


__device__ __forceinline__ void p8_gn(Frame& F, bool probe) {
    const int gw = blockIdx.x * NWAVES + F.wave, NGW = F.G * NWAVES, lane = F.lane;
    const bf16* O = (const bf16*)(F.ws + WS_VD); bf16* SG = (bf16*)(F.ws + WS_SG); const float* gnw = F.in[14];
    for (int item = gw; item < T * 4; item += NGW) {
        const size_t off = (size_t)item * 512 + 8 * lane; const int hcol = (item & 3) * 512 + 8 * lane;
        const u32x4 ov = *(const u32x4*)(O + off), gv = *(const u32x4*)(SG + off);
        float o[8] = {bf_lo(ov.x), bf_hi(ov.x), bf_lo(ov.y), bf_hi(ov.y), bf_lo(ov.z), bf_hi(ov.z), bf_lo(ov.w), bf_hi(ov.w)};
        float sg[8] = {bf_lo(gv.x), bf_hi(gv.x), bf_lo(gv.y), bf_hi(gv.y), bf_lo(gv.z), bf_hi(gv.z), bf_lo(gv.w), bf_hi(gv.w)};
        float s = 0.f;
#pragma unroll
        for (int j = 0; j < 8; ++j) s += o[j];
        const float mean = wave_sum(s) * (1.0f / 512.0f); float q = 0.f;
#pragma unroll
        for (int j = 0; j < 8; ++j) { o[j] -= mean; q += o[j] * o[j]; }
        const float rs = rsqrtf(wave_sum(q) * (1.0f / 512.0f) + EPS);
        const f32x4 w0 = *(const f32x4*)(gnw + hcol), w1 = *(const f32x4*)(gnw + hcol + 4);
        float y[8];
#pragma unroll
        for (int j = 0; j < 8; ++j) y[j] = sg[j] * o[j] * rs * (j < 4 ? w0[j] : w1[j - 4]);
        u32x4 wv; wv.x = pk2(y[0], y[1]); wv.y = pk2(y[2], y[3]); wv.z = pk2(y[4], y[5]); wv.w = pk2(y[6], y[7]);
        if (!probe) *(u32x4*)(SG + off) = wv; else asm volatile("" :: "v"(wv.x), "v"(wv.y), "v"(wv.z), "v"(wv.w));
    }
}
}
namespace mk {
namespace cg = cooperative_groups;
enum { PH_PREP = 0, PH_S5 = 1, PH_GLU = 2, PH_GU0 = 3, PH_DN0 = 4, PH_PROJ = 5, PH_SCORE = 6, PH_REC = 7, PH_GN = 8, PH_WO = 9, PH_GU1 = 10, PH_DN1 = 11, PH_FINAL = 12, PH_ADAPT = 13 };
struct Args { const float* in[21]; float* out; unsigned char* ws; unsigned mask; unsigned flags; };

__global__ void __launch_bounds__(NTHREADS, 2) mk_fwd(Args a) {
    extern __shared__ __attribute__((aligned(16))) unsigned char lds_raw[];
    cg::grid_group grid = cg::this_grid();
    Frame F;
    F.lds = (LAS unsigned char*)lds_raw; F.tid = threadIdx.x; F.lane = F.tid & 63; F.wave = __builtin_amdgcn_readfirstlane(F.tid >> 6); F.G = gridDim.x;
    F.in = a.in; F.out = a.out; F.ws = a.ws; F.pp = (a.flags & 1u) ? (bf16*)(a.ws + 304 * MiB) : (bf16*)a.out;
    unsigned char* ws = a.ws; const unsigned mask = a.mask; const bool probe = (a.flags & 1u) != 0u;
    float* RX = probe ? (float*)(ws + 304 * MiB) : a.out; bf16* RXB = probe ? (bf16*)(ws + 432 * MiB) : (bf16*)(ws + WS_XB); float* RSSQ = probe ? (float*)(ws + 496 * MiB) : (float*)(ws + WS_SSQ);
    volatile LAS unsigned* MISC = (volatile LAS unsigned*)(F.lds + LDS_BYTES - 256);
    if (F.tid < 64) MISC[F.tid] = 0u;
    __syncthreads();
    XcdBarrier bar = xcd_barrier_post((unsigned*)(ws + WS_CTL) + 1024, MISC + 8);
    bool dirty = false; int nseam = 0;
#define SEAM() do { if (dirty) { xcd_barrier(bar); ++nseam; } dirty = true; } while (0)
#define ON(p) (mask & (1u << (p)))
    bf16* XB = (bf16*)(ws + WS_XB); float* SSQ = (float*)(ws + WS_SSQ);
    typedef pg8::StaticOrder SO;

    if (ON(PH_PREP) || ON(PH_ADAPT)) {
        SEAM();
        if (ON(PH_PREP)) { if (!(a.flags & 2u)) p0_weights(F); if (!(a.flags & 4u)) p0_s5consts(F); if (!(a.flags & 8u)) rows_to_u(F, a.in[0], a.in[1], (bf16*)(ws + WS_U)); }
    }
    if (ON(PH_S5)) { SEAM(); p1_s5(F); }
    if (ON(PH_GLU)) { SEAM();
        pg8::Gemm g{(const bf16*)(ws + WS_YG), (const bf16*)(ws + WS_WGLU), T, D, D}; SO S; S.init(T, D, F.G, (int)blockIdx.x);
        pg8::EpiResid<true> E{a.in[0], RXB, RSSQ, (const bf16*)(ws + WS_YG), a.in[11]};
        pg8::gemm_phase<pg8::EpiResid<true>, SO, true, true>(F.lds, g, S, E); }
#define FFN_PHASES(l) do { \
        if (ON(l ? PH_GU1 : PH_GU0)) { SEAM(); \
            pg8::Gemm g{XB, (const bf16*)(ws + (l ? WS_WGU1 : WS_WGU0)), T, 2 * FF, D}; SO S; S.init(T, 2 * FF, F.G, (int)blockIdx.x); \
            pg8::EpiGateUp E{(bf16*)(ws + WS_H), SSQ, a.flags & 0x70u, F.lds + pg8::STAGE_BYTES}; \
            pg8::gemm_phase<pg8::EpiGateUp, SO, true, true>(F.lds, g, S, E); } \
        if (ON(l ? PH_DN1 : PH_DN0)) { SEAM(); \
            pg8::Gemm g{(const bf16*)(ws + WS_H), (const bf16*)(ws + (l ? WS_WDN1 : WS_WDN0)), T, D, FF}; SO S; S.init(T, D, F.G, (int)blockIdx.x); \
            pg8::EpiResid<false> E{nullptr, RXB, RSSQ, nullptr, nullptr}; \
            pg8::gemm_phase<pg8::EpiResid<false>, SO, true, true>(F.lds, g, S, E); } } while (0)
    FFN_PHASES(0);
    if (ON(PH_PROJ)) { SEAM();
        pg8::Gemm g{XB, (const bf16*)(ws + WS_WQKVG), T, PW, D}; SO S; S.init(T, PW, F.G, (int)blockIdx.x);
        pg8::EpiProj E{(bf16*)(ws + WS_Q), (bf16*)(ws + WS_K), (bf16*)(ws + WS_VD), (bf16*)(ws + WS_SG), SSQ, F.lds + pg8::STAGE_BYTES};
        pg8::gemm_phase<pg8::EpiProj, SO, true, true>(F.lds, g, S, E); }
    if (ON(PH_SCORE)) { SEAM(); p6_scores(F); }
    if (ON(PH_REC)) { SEAM(); p7_ret(F, probe); }
    if (ON(PH_GN)) { SEAM(); p8_gn(F, probe); }
    if (ON(PH_WO)) { SEAM();
        pg8::Gemm g{(const bf16*)(ws + WS_SG), (const bf16*)(ws + WS_WO), T, D, 2048}; SO S; S.init(T, D, F.G, (int)blockIdx.x);
        pg8::EpiResid<false> E{nullptr, RXB, RSSQ, nullptr, nullptr};
        pg8::gemm_phase<pg8::EpiResid<false>, SO, true, true>(F.lds, g, S, E); }
    FFN_PHASES(1);
#undef FFN_PHASES
    if (ON(PH_FINAL)) { SEAM(); rows_final(F, XB, a.in[20], RX); }
#undef SEAM
#undef ON
}

static int g_grid = 0;
inline void launch(void* const* d_in, void* d_out, void* d_ws, unsigned mask, hipStream_t stream, unsigned flags = 0) {
    if (g_grid == 0) {
        int dev = 0, cus = 0, per_cu = 0;
        hipGetDevice(&dev); hipDeviceGetAttribute(&cus, hipDeviceAttributeMultiprocessorCount, dev);
        hipFuncSetAttribute((const void*)mk_fwd, hipFuncAttributeMaxDynamicSharedMemorySize, LDS_BYTES);
        hipOccupancyMaxActiveBlocksPerMultiprocessor(&per_cu, (const void*)mk_fwd, NTHREADS, LDS_BYTES);
        if (per_cu < 1) { fprintf(stderr, "mk_fwd: occupancy query says %d blocks per CU\n", per_cu); per_cu = 1; }
        g_grid = cus;
        (void)hipGetLastError();
    }
    (void)hipMemsetAsync(d_ws, 0, 65536, stream);
    Args a{};
    for (int i = 0; i < 21; ++i) a.in[i] = (const float*)d_in[i];
    a.out = (float*)d_out; a.ws = (unsigned char*)d_ws; a.mask = mask; a.flags = flags;
    void* args[] = {&a};
    hipError_t e = hipLaunchCooperativeKernel((const void*)mk_fwd, dim3(g_grid), dim3(NTHREADS), args, LDS_BYTES, stream);
    if (e != hipSuccess) fprintf(stderr, "mk_fwd: cooperative launch failed: %s (grid %d)\n", hipGetErrorString(e), g_grid);
}
}
#ifndef MK_MODE
#define MK_MODE 1
#endif
#define BIT(p) (1u << (mk::p))
extern "C" void kernel_launch(void* const* d_in, const int* in_sizes, int n_in, void* d_out, int out_size, void* d_ws, size_t ws_size, hipStream_t stream) {
    const float* x = (const float*)d_in[0]; float* out = (float*)d_out; char* ws = (char*)d_ws;
#if MK_MODE == 1
    nv::s5_sublayer(d_in, x, out, ws, stream);
    mk::launch(d_in, d_out, d_ws, BIT(PH_ADAPT) | BIT(PH_PREP) | BIT(PH_GU0) | BIT(PH_DN0), stream);
    nv::ret_sublayer(d_in, out, ws, stream);
    mk::launch(d_in, d_out, d_ws, BIT(PH_ADAPT) | BIT(PH_PREP) | BIT(PH_GU1) | BIT(PH_DN1) | BIT(PH_FINAL), stream);
#elif MK_MODE == 2
    mk::launch(d_in, d_out, d_ws, BIT(PH_PREP) | BIT(PH_S5) | BIT(PH_GLU) | BIT(PH_GU0) | BIT(PH_DN0), stream);
    nv::ret_sublayer(d_in, out, ws, stream);
    mk::launch(d_in, d_out, d_ws, BIT(PH_ADAPT) | BIT(PH_PREP) | BIT(PH_GU1) | BIT(PH_DN1) | BIT(PH_FINAL), stream);
#else
    mk::launch(d_in, d_out, d_ws, 0x1fffu, stream);
#ifdef PROBE_MASK
#ifndef PROBE_FLAGS
#define PROBE_FLAGS 0u
#endif
    for (int r = 0; r < PROBE_REP; ++r) mk::launch(d_in, d_out, d_ws, PROBE_MASK, stream, 1u | PROBE_FLAGS);
#endif
#endif
}
```
